# Optimizing an MI355X kernel written in HIP

```python
import math
import numpy as np
import jax
import jax.numpy as jnp
from jax import lax

D_MODEL = 1024
BATCH = 8
SEQ = 4096
DEPTH = 2

CHUNK = 64
Q_BLOCK = 128
HEAD_DIM = 64
MIX_WIDTH = D_MODEL

SB_HEADS = 6
SB_WIDTH = SB_HEADS * HEAD_DIM
CA_HEADS = 6
CA_WIDTH = CA_HEADS * HEAD_DIM
CA_LEFT_CHUNKS = 8
CA_BAND = (CA_LEFT_CHUNKS + 1) * CHUNK
MAX_REL = 256
DA_HEADS = 4
DA_VDIM = 64
DA_QKDIM = 32
DA_WIDTH = DA_HEADS * DA_VDIM

IN_WIDTH = 4 * (SB_WIDTH + CA_WIDTH + DA_WIDTH)
ROPE_THETA = 10000.0
EPS = 1e-6

kernel_name = "hybrid_stickbreak_chunkrel_diffattn_block"


def rmsnorm(x, g):
    xf = x.astype(jnp.float32)
    y = xf * lax.rsqrt(jnp.mean(xf * xf, axis=-1, keepdims=True) + EPS)
    return (y * g.astype(jnp.float32)).astype(x.dtype)


def rotary(x, positions):
    d = x.shape[-1]
    half = d // 2
    inv_freq = ROPE_THETA ** (-np.arange(half, dtype=np.float32) / half)
    ang = positions.astype(jnp.float32)[..., None] * inv_freq
    ang = ang.reshape(ang.shape[:2] + (1,) * (x.ndim - 3) + (half,))
    cos, sin = jnp.cos(ang), jnp.sin(ang)
    xf = x.astype(jnp.float32)
    x1, x2 = xf[..., :half], xf[..., half:]
    return jnp.concatenate([x1 * cos - x2 * sin, x2 * cos + x1 * sin], axis=-1).astype(x.dtype)


def stick_breaking_attention(q, k, v):
    _, _, s_len, d = q.shape
    scale = d ** -0.5
    outs = []
    for i in range(s_len // Q_BLOCK):
        lo, hi = i * Q_BLOCK, (i + 1) * Q_BLOCK
        z = jnp.einsum('bhqd,bhkd->bhqk', q[:, :, lo:hi], k[:, :, :hi]).astype(jnp.float32) * scale
        strict = np.arange(hi)[None, :] < np.arange(lo, hi)[:, None]
        log_1m_beta = jnp.where(strict, jax.nn.log_sigmoid(-z), 0.0)
        between = lax.cumsum(log_1m_beta, axis=3, reverse=True) - log_1m_beta
        w = jnp.where(strict, jnp.exp(jax.nn.log_sigmoid(z) + between), 0.0)
        outs.append(jnp.einsum('bhqk,bhkd->bhqd', w.astype(v.dtype), v[:, :, :hi]))
    return jnp.concatenate(outs, axis=2)


def chunk_relpos_attention(q, k, v, rel_table):
    b, h, s_len, d = q.shape
    nc = s_len // CHUNK
    scale = d ** -0.5
    qc = q.reshape(b, h, nc, CHUNK, d)
    pad = ((0, 0), (0, 0), (CA_LEFT_CHUNKS * CHUNK, 0), (0, 0))
    kc = jnp.pad(k, pad).reshape(b, h, nc + CA_LEFT_CHUNKS, CHUNK, d)
    vc = jnp.pad(v, pad).reshape(b, h, nc + CA_LEFT_CHUNKS, CHUNK, d)
    k_band = jnp.concatenate([kc[:, :, o:o + nc] for o in range(CA_LEFT_CHUNKS + 1)], axis=3)
    v_band = jnp.concatenate([vc[:, :, o:o + nc] for o in range(CA_LEFT_CHUNKS + 1)], axis=3)
    scores = jnp.einsum('bhcqd,bhckd->bhcqk', qc, k_band).astype(jnp.float32) * scale
    rel = (CA_LEFT_CHUNKS * CHUNK + np.arange(CHUNK)[:, None]) - np.arange(CA_BAND)[None, :]
    rel_idx = np.clip(rel, -MAX_REL, MAX_REL) + MAX_REL
    bias = rel_table.astype(jnp.float32)[:, rel_idx]
    key_chunk = np.arange(nc)[:, None] - CA_LEFT_CHUNKS + (np.arange(CA_BAND) // CHUNK)[None, :]
    valid = key_chunk >= 0
    scores = jnp.where(valid[None, None, :, None, :], scores + bias[None, :, None], -jnp.inf)
    probs = jax.nn.softmax(scores, axis=-1).astype(v.dtype)
    out = jnp.einsum('bhcqk,bhckd->bhcqd', probs, v_band)
    return out.reshape(b, h, s_len, d)


def diff_attention(q, k, v, lam, lam_init, subln_g):
    _, _, _, s_len, dk = q.shape
    scale = dk ** -0.5
    outs = []
    for i in range(s_len // Q_BLOCK):
        lo, hi = i * Q_BLOCK, (i + 1) * Q_BLOCK
        s = jnp.einsum('bhnqd,bhnkd->bhnqk', q[:, :, :, lo:hi], k[:, :, :, :hi]).astype(jnp.float32) * scale
        mask = (np.arange(hi) // CHUNK)[None, :] <= (np.arange(lo, hi) // CHUNK)[:, None]
        p = jax.nn.softmax(jnp.where(mask, s, -jnp.inf), axis=-1)
        w = p[:, :, 0] - lam * p[:, :, 1]
        outs.append(jnp.einsum('bhqk,bhkd->bhqd', w.astype(v.dtype), v[:, :, :hi]))
    o = jnp.concatenate(outs, axis=2)
    return rmsnorm(o, subln_g) * (1.0 - lam_init)


def hybrid_layer(x, positions, w_in, w_out, pre_g, post_g, rel_table,
                 lq1, lk1, lq2, lk2, subln_g, lam_init):
    b, s_len, _ = x.shape
    h = rmsnorm(x, pre_g)
    proj = h @ w_in
    a_part = proj[..., :4 * SB_WIDTH]
    b_part = proj[..., 4 * SB_WIDTH:4 * (SB_WIDTH + CA_WIDTH)]
    c_part = proj[..., 4 * (SB_WIDTH + CA_WIDTH):]

    def heads(t, n):
        return t.reshape(b, s_len, n, -1).transpose(0, 2, 1, 3)

    def merge(t):
        return t.transpose(0, 2, 1, 3).reshape(b, s_len, -1)

    qa, ka, va, ga = jnp.split(a_part, 4, axis=-1)
    ya = stick_breaking_attention(heads(qa, SB_HEADS), heads(ka, SB_HEADS), heads(va, SB_HEADS))
    ya = merge(ya) * jax.nn.silu(ga)

    qb, kb, vb, gb = jnp.split(b_part, 4, axis=-1)
    yb = chunk_relpos_attention(heads(qb, CA_HEADS), heads(kb, CA_HEADS), heads(vb, CA_HEADS), rel_table)
    yb = merge(yb) * jax.nn.silu(gb)

    qc, kc, vc, gc = jnp.split(c_part, 4, axis=-1)
    qc = rotary(qc.reshape(b, s_len, DA_HEADS, 2, DA_QKDIM), positions).transpose(0, 2, 3, 1, 4)
    kc = rotary(kc.reshape(b, s_len, DA_HEADS, 2, DA_QKDIM), positions).transpose(0, 2, 3, 1, 4)
    lam = (jnp.exp(jnp.sum(lq1.astype(jnp.float32) * lk1.astype(jnp.float32)))
           - jnp.exp(jnp.sum(lq2.astype(jnp.float32) * lk2.astype(jnp.float32))) + lam_init)
    yc = diff_attention(qc, kc, heads(vc, DA_HEADS), lam, lam_init, subln_g)
    yc = merge(yc) * jax.nn.silu(gc)

    y = jnp.concatenate([ya, yb, yc], axis=-1) @ w_out
    return x + rmsnorm(y, post_g)


def setup_inputs(seed: int = 0) -> dict:
    key = jax.random.key(seed)
    ks = jax.random.split(key, 12)
    x = jax.random.normal(ks[0], (BATCH, SEQ, D_MODEL), jnp.float32)
    positions = jnp.broadcast_to(jnp.arange(SEQ, dtype=jnp.int32), (BATCH, SEQ))
    w_in = jax.random.normal(ks[1], (DEPTH, D_MODEL, IN_WIDTH), jnp.float32) * D_MODEL ** -0.5
    w_out = jax.random.normal(ks[2], (DEPTH, MIX_WIDTH, D_MODEL), jnp.float32) * MIX_WIDTH ** -0.5
    pre_gain = 1.0 + 0.02 * jax.random.normal(ks[3], (DEPTH, D_MODEL), jnp.float32)
    post_gain = 1.0 + 0.02 * jax.random.normal(ks[4], (DEPTH, D_MODEL), jnp.float32)
    rel_bias = 0.1 * jax.random.normal(ks[5], (DEPTH, CA_HEADS, 2 * MAX_REL + 1), jnp.float32)
    lambda_q1 = 0.1 * jax.random.normal(ks[6], (DEPTH, DA_QKDIM), jnp.float32)
    lambda_k1 = 0.1 * jax.random.normal(ks[7], (DEPTH, DA_QKDIM), jnp.float32)
    lambda_q2 = 0.1 * jax.random.normal(ks[8], (DEPTH, DA_QKDIM), jnp.float32)
    lambda_k2 = 0.1 * jax.random.normal(ks[9], (DEPTH, DA_QKDIM), jnp.float32)
    subln_gain = 1.0 + 0.02 * jax.random.normal(ks[10], (DEPTH, DA_VDIM), jnp.float32)
    return {"x": x, "positions": positions, "w_in": w_in, "w_out": w_out,
            "pre_gain": pre_gain, "post_gain": post_gain, "rel_bias": rel_bias,
            "lambda_q1": lambda_q1, "lambda_k1": lambda_k1, "lambda_q2": lambda_q2,
            "lambda_k2": lambda_k2, "subln_gain": subln_gain}


def reference(x, positions, w_in, w_out, pre_gain, post_gain, rel_bias,
              lambda_q1, lambda_k1, lambda_q2, lambda_k2, subln_gain):
    for layer in range(DEPTH):
        lam_init = 0.8 - 0.6 * math.exp(-0.3 * layer)
        x = hybrid_layer(x, positions, w_in[layer], w_out[layer], pre_gain[layer], post_gain[layer],
                         rel_bias[layer], lambda_q1[layer], lambda_k1[layer], lambda_q2[layer],
                         lambda_k2[layer], subln_gain[layer], lam_init)
    return x
```

```cpp
#include <hip/hip_runtime.h>
#include <hip/hip_cooperative_groups.h>
#include <cstdio>
#include <cstdint>
#include <cmath>
namespace cg = cooperative_groups;
namespace pg8 {
#define PG8_LAS __attribute__((address_space(3)))
typedef unsigned short bf16_t;
typedef short bf16x8 __attribute__((ext_vector_type(8)));
typedef float f32x4 __attribute__((ext_vector_type(4)));
typedef unsigned u32x4 __attribute__((ext_vector_type(4)));
constexpr int BM = 256, BK = 64, HALF = 128, HTB = HALF * BK * 2  , STAGE_BYTES = 8 * HTB, NXCD = 8, WGM = 8;

__host__ __device__ __forceinline__ int lds_byte(int r, int c) { const int st = (r >> 4) * 2 + (c >> 5), rr = r & 15, cc = c & 31, ob = rr * 64 + cc * 2; return st * 1024 + (ob ^ (((ob >> 9) & 1) << 5)); }
__host__ __device__ __forceinline__ void stage_rc(int b, int& R, int& C) { const int st = b / 1024, sb = b % 1024, swz = sb ^ (((sb >> 9) & 1) << 5); R = (st >> 1) * 16 + swz / 64; C = (st & 1) * 32 + (swz % 64) / 2; }
__host__ __device__ __forceinline__ int perm32(int rho) { const int n = rho >> 4, i = rho & 15; return 8 * (i >> 2) + 4 * n + (i & 3); }

struct Unit { int pm, pn; };
struct Gemm { const bf16_t* A; const bf16_t* Bt; int M, N, K; };

struct StaticOrder {
    int nM, nN, nwg, G, c;
    __host__ __device__ void init(int M, int N, int G_, int c_) { nM = M / BM; nN = N / BM; nwg = nM * nN; G = G_; c = c_; }
    __host__ __device__ bool next(int i, Unit& u) const {
        const long L = (long)i * G + c; if (L >= nwg) return false;
        int wgid = (int)L; { const int q = nwg / NXCD, r = nwg % NXCD, xcd = wgid % NXCD, off = wgid / NXCD; wgid = (xcd < r ? xcd * (q + 1) : r * (q + 1) + (xcd - r) * q) + off; }
        const int nig = WGM * nN, gid = wgid / nig, fm = gid * WGM, gsz = (nM - fm) < WGM ? (nM - fm) : WGM;
        u.pm = fm + ((wgid % nig) % gsz); u.pn = (wgid % nig) / gsz; return true;
    }
    __device__ __forceinline__ void a_ready(const Unit&) const {}
    __device__ __forceinline__ void done(const Unit&) const {}
};


typedef float f32x2 __attribute__((ext_vector_type(2)));
typedef __bf16 bf16x2_t __attribute__((ext_vector_type(2)));
__device__ __forceinline__ unsigned cvt_pk_bf16(float lo, float hi) { f32x2 v = {lo, hi}; bf16x2_t b = __builtin_convertvector(v, bf16x2_t); return __builtin_bit_cast(unsigned, b); }

struct EpiPlain {
    static constexpr bool PERM = true, AFTER_DRAIN = false;
    bf16_t* O; int ldc;
    __device__ __forceinline__ void operator()(const f32x4 (&acc)[2][2][4][2], const Unit& u, int wr, int wc, int fr, int fq) const {
        const int row0 = u.pm * BM + wr * 64 + fr; const int col0 = u.pn * BM + wc * 32 + 8 * fq;
#pragma unroll
        for (int ai = 0; ai < 2; ++ai)
#pragma unroll
            for (int m = 0; m < 4; ++m) { bf16_t* rowp = O + (size_t)(row0 + ai * HALF + m * 16) * ldc + col0;
#pragma unroll
                for (int bj = 0; bj < 2; ++bj) { const f32x4 v0 = acc[ai][bj][m][0], v1 = acc[ai][bj][m][1];
                    u32x4 w; w.x = cvt_pk_bf16(v0[0], v0[1]); w.y = cvt_pk_bf16(v0[2], v0[3]); w.z = cvt_pk_bf16(v1[0], v1[1]); w.w = cvt_pk_bf16(v1[2], v1[3]);
                    *(u32x4*)(rowp + bj * HALF) = w; } }
    }
};
struct EpiQKG {
    static constexpr bool PERM = true, AFTER_DRAIN = false;
    bf16_t* O; const float* cs; float qsc_ab, qsc_c;
    __device__ __forceinline__ void operator()(const f32x4 (&acc)[2][2][4][2], const Unit& u, int wr, int wc, int fr, int fq) const {
        const int row0 = u.pm * BM + wr * 64 + fr; const int col0 = u.pn * BM + wc * 32 + 8 * fq;
        const int sub = u.pn & 3, tm = u.pn >> 2;
        const bool rot = (tm < 2) && (sub == 3);
        float sc = 1.f; if (tm == 0) sc = (sub == 3) ? qsc_c : qsc_ab;
        const float sgn = (fq < 2) ? -1.f : 1.f;
#pragma unroll
        for (int ai = 0; ai < 2; ++ai)
#pragma unroll
            for (int m = 0; m < 4; ++m) { const int row = row0 + ai * HALF + m * 16; bf16_t* rowp = O + (size_t)row * 3072 + col0;
                f32x4 c0 = {1.f, 0.f, 1.f, 0.f}, c1 = c0, c2 = c0, c3 = c0;
                if (rot) { const f32x4* cp = (const f32x4*)(cs + (size_t)row * 32 + (fq & 1) * 16); c0 = cp[0]; c1 = cp[1]; c2 = cp[2]; c3 = cp[3]; }
#pragma unroll
                for (int bj = 0; bj < 2; ++bj) { f32x4 v0 = acc[ai][bj][m][0], v1 = acc[ai][bj][m][1];
                    if (rot) {
                        f32x4 p0, p1;
#pragma unroll
                        for (int j = 0; j < 4; ++j) { p0[j] = __shfl_xor(v0[j], 32); p1[j] = __shfl_xor(v1[j], 32); }
                        f32x4 o0, o1;
                        o0[0] = v0[0] * c0[0] + sgn * p0[0] * c0[1]; o0[1] = v0[1] * c0[2] + sgn * p0[1] * c0[3];
                        o0[2] = v0[2] * c1[0] + sgn * p0[2] * c1[1]; o0[3] = v0[3] * c1[2] + sgn * p0[3] * c1[3];
                        o1[0] = v1[0] * c2[0] + sgn * p1[0] * c2[1]; o1[1] = v1[1] * c2[2] + sgn * p1[1] * c2[3];
                        o1[2] = v1[2] * c3[0] + sgn * p1[2] * c3[1]; o1[3] = v1[3] * c3[2] + sgn * p1[3] * c3[3];
                        v0 = o0; v1 = o1;
                    }
                    v0 = v0 * sc; v1 = v1 * sc;
                    u32x4 w; w.x = cvt_pk_bf16(v0[0], v0[1]); w.y = cvt_pk_bf16(v0[2], v0[3]); w.z = cvt_pk_bf16(v1[0], v1[1]); w.w = cvt_pk_bf16(v1[2], v1[3]);
                    *(u32x4*)(rowp + bj * HALF) = w; } }
    }
};
struct EpiF32 {
    static constexpr bool PERM = false, AFTER_DRAIN = false;
    float* O; int ldc;
    __device__ __forceinline__ void operator()(const f32x4 (&acc)[2][2][4][2], const Unit& u, int wr, int wc, int fr, int fq) const {
        const int row0 = u.pm * BM + wr * 64 + fr; const int col0 = u.pn * BM + wc * 32 + 4 * fq;
#pragma unroll
        for (int ai = 0; ai < 2; ++ai)
#pragma unroll
            for (int m = 0; m < 4; ++m) { float* rowp = O + (size_t)(row0 + ai * HALF + m * 16) * ldc + col0;
#pragma unroll
                for (int bj = 0; bj < 2; ++bj)
#pragma unroll
                    for (int n = 0; n < 2; ++n) *(f32x4*)(rowp + bj * HALF + n * 16) = acc[ai][bj][m][n]; }
    }
};

template <class Epi, class Sched, bool ALIGN_EPI = false, bool SP2 = false>
__device__ __forceinline__ void gemm_phase(PG8_LAS unsigned char* lds, const Gemm g, const Sched& S, const Epi& E, const int wave_in) {
    int lane_; asm volatile("v_mbcnt_lo_u32_b32 %0, -1, 0\n\tv_mbcnt_hi_u32_b32 %0, -1, %0" : "=v"(lane_)); int wid_ = wave_in; asm volatile("" : "+s"(wid_)); const int wid = wid_, lane = lane_, tid = wid * 64 + lane, wr = wid >> 2, wc = wid & 3, fr = lane & 15, fq = lane >> 4;
    const int K = g.K, nt = K / BK;
    unsigned voffA[2], voffB[2];
#pragma unroll
    for (int i = 0; i < 2; ++i) { int R, C; stage_rc(tid * 16 + i * 8192, R, C); const int Rb = Epi::PERM ? ((R & ~31) + perm32(R & 31)) : R;
        voffA[i] = (unsigned)(R * K + C) * 2u; voffB[i] = (unsigned)(Rb * K + C) * 2u; }
    const size_t kstep = (size_t)(BK * 2);
    const size_t hstep = (size_t)HALF * K * 2;
    const size_t tstep = 2 * hstep;
    const unsigned ldsw = (unsigned)wid * 1024u;
    const int aoff = lds_byte(wr * 64 + fr, fq * 8), boff = lds_byte(wc * 32 + fr, fq * 8);
#define PG8_SA(b, h) (((b) * 2 + (h)) * HTB)
#define PG8_SB(b, h) ((4 + (b) * 2 + (h)) * HTB)
#define PG8_STAGE(bufoff, gbase, voff) do { _Pragma("unroll") for (int _i = 0; _i < 2; ++_i) \
        __builtin_amdgcn_global_load_lds((const unsigned*)((const char*)(gbase) + (voff)[_i]), (PG8_LAS unsigned*)(lds + (bufoff) + ldsw + _i * 8192), 16, 0, 0); } while (0)
#define PG8_LDA(dst, b, h) do { _Pragma("unroll") for (int m = 0; m < 4; ++m) _Pragma("unroll") for (int k = 0; k < 2; ++k) dst[m][k] = *(const PG8_LAS bf16x8*)(lds + PG8_SA(b, h) + aoff + m * 2048 + k * 1024); } while (0)
#define PG8_LDB(dst, b, h) do { _Pragma("unroll") for (int n = 0; n < 2; ++n) _Pragma("unroll") for (int k = 0; k < 2; ++k) dst[n][k] = *(const PG8_LAS bf16x8*)(lds + PG8_SB(b, h) + boff + n * 2048 + k * 1024); } while (0)
#define PG8_MMA(ai, bj, At, Bt) do { __builtin_amdgcn_s_setprio(1); _Pragma("unroll") for (int m = 0; m < 4; ++m) _Pragma("unroll") for (int n = 0; n < 2; ++n) _Pragma("unroll") for (int k = 0; k < 2; ++k) \
        acc[ai][bj][m][n] = __builtin_amdgcn_mfma_f32_16x16x32_bf16(Bt[n][k], At[m][k], acc[ai][bj][m][n], 0, 0, 0); __builtin_amdgcn_s_setprio(0); } while (0)
#define PG8_WAIT_V(n) asm volatile("s_waitcnt vmcnt(" #n ")" ::: "memory")
#define PG8_WAIT_L(n) asm volatile("s_waitcnt lgkmcnt(" #n ")" ::: "memory")
#define PG8_BAR __builtin_amdgcn_s_barrier()
#define PG8_SCHED __builtin_amdgcn_sched_barrier(0)
    Unit cur, nxt; int ui = 0;
    if (!S.next(0, cur)) return;
    f32x4 acc[2][2][4][2];
#pragma unroll
    for (int a = 0; a < 2; ++a)
#pragma unroll
        for (int b = 0; b < 2; ++b)
#pragma unroll
            for (int m = 0; m < 4; ++m)
#pragma unroll
                for (int n = 0; n < 2; ++n) acc[a][b][m][n] = (f32x4){0.f, 0.f, 0.f, 0.f};
    bf16x8 At[4][2], B0[2][2], B1[2][2];
    const char* cA = (const char*)g.A + (size_t)cur.pm * tstep; const char* cB = (const char*)g.Bt + (size_t)cur.pn * tstep;
    S.a_ready(cur);
    if constexpr (SP2) {
        PG8_STAGE(PG8_SB(0, 0), cB, voffB); PG8_STAGE(PG8_SB(0, 1), cB + hstep, voffB); PG8_STAGE(PG8_SA(0, 0), cA, voffA); PG8_STAGE(PG8_SA(0, 1), cA + hstep, voffA);
        if (wr == 1) PG8_BAR;
        PG8_WAIT_V(2); PG8_BAR;
        PG8_STAGE(PG8_SB(1, 0), cB + kstep, voffB); PG8_STAGE(PG8_SA(1, 0), cA + kstep, voffA); PG8_STAGE(PG8_SB(1, 1), cB + hstep + kstep, voffB);
        PG8_WAIT_V(6); PG8_BAR;
    } else {
        PG8_STAGE(PG8_SB(0, 0), cB, voffB); PG8_STAGE(PG8_SA(0, 0), cA, voffA); PG8_STAGE(PG8_SB(0, 1), cB + hstep, voffB); PG8_STAGE(PG8_SA(0, 1), cA + hstep, voffA);
        if (wr == 1) PG8_BAR;
        PG8_WAIT_V(4); PG8_BAR;
        PG8_STAGE(PG8_SB(1, 0), cB + kstep, voffB); PG8_STAGE(PG8_SA(1, 0), cA + kstep, voffA); PG8_STAGE(PG8_SB(1, 1), cB + hstep + kstep, voffB);
        PG8_WAIT_V(6); PG8_BAR;
    }
    for (;;) {
        const bool has_next = S.next(ui + 1, nxt);
        const char* nA = has_next ? (const char*)g.A + (size_t)nxt.pm * tstep : cA; const char* nB = has_next ? (const char*)g.Bt + (size_t)nxt.pn * tstep : cB;
        for (int t = 0; t < nt; t += 2) {
            const bool last = (t == nt - 2);
            const char* a1 = cA + (size_t)(t + 1) * kstep;
            const char* a2 = last ? nA : cA + (size_t)(t + 2) * kstep; const char* b2 = last ? nB : cB + (size_t)(t + 2) * kstep;
            const char* a3 = a2 + kstep; const char* b3 = b2 + kstep;
            if (last && has_next) S.a_ready(nxt);
            if constexpr (SP2) {
            PG8_LDB(B0, 0, 0); PG8_LDB(B1, 0, 1); PG8_SCHED; PG8_LDA(At, 0, 0); PG8_STAGE(PG8_SA(1, 1), a1 + hstep, voffA);
            PG8_WAIT_V(8); PG8_WAIT_L(0); PG8_BAR; PG8_MMA(0, 0, At, B0); PG8_MMA(0, 1, At, B1); PG8_BAR; PG8_SCHED;
            PG8_LDA(At, 0, 1); PG8_STAGE(PG8_SB(0, 0), b2, voffB); PG8_STAGE(PG8_SB(0, 1), b2 + hstep, voffB); PG8_STAGE(PG8_SA(0, 0), a2, voffA);
            PG8_WAIT_V(8); PG8_WAIT_L(0); PG8_BAR; PG8_MMA(1, 0, At, B0); PG8_MMA(1, 1, At, B1); PG8_BAR; PG8_SCHED;
            PG8_LDB(B0, 1, 0); PG8_LDB(B1, 1, 1); PG8_SCHED; PG8_LDA(At, 1, 0); PG8_STAGE(PG8_SA(0, 1), a2 + hstep, voffA);
            PG8_WAIT_V(8); PG8_WAIT_L(0); PG8_BAR; PG8_MMA(0, 0, At, B0); PG8_MMA(0, 1, At, B1); PG8_BAR; PG8_SCHED;
            PG8_LDA(At, 1, 1); PG8_STAGE(PG8_SB(1, 0), b3, voffB); PG8_STAGE(PG8_SB(1, 1), b3 + hstep, voffB); PG8_STAGE(PG8_SA(1, 0), a3, voffA);
            PG8_WAIT_V(8); PG8_WAIT_L(0); PG8_BAR; PG8_MMA(1, 0, At, B0); PG8_MMA(1, 1, At, B1); PG8_BAR; PG8_SCHED;
            } else {
            PG8_LDB(B0, 0, 0); PG8_SCHED; PG8_LDA(At, 0, 0); PG8_STAGE(PG8_SA(1, 1), a1 + hstep, voffA);
            PG8_WAIT_L(8); PG8_BAR; PG8_WAIT_L(0); PG8_MMA(0, 0, At, B0); PG8_BAR; PG8_SCHED;
            PG8_LDB(B1, 0, 1); PG8_STAGE(PG8_SB(0, 0), b2, voffB);
            PG8_BAR; PG8_WAIT_L(0); PG8_MMA(0, 1, At, B1); PG8_BAR;
            PG8_LDA(At, 0, 1); PG8_STAGE(PG8_SA(0, 0), a2, voffA);
            PG8_BAR; PG8_WAIT_L(0); PG8_MMA(1, 0, At, B0); PG8_BAR; PG8_SCHED;
            PG8_STAGE(PG8_SB(0, 1), b2 + hstep, voffB);
            PG8_WAIT_V(6); PG8_BAR; PG8_MMA(1, 1, At, B1); PG8_BAR;
            PG8_LDB(B0, 1, 0); PG8_SCHED; PG8_LDA(At, 1, 0); PG8_STAGE(PG8_SA(0, 1), a2 + hstep, voffA);
            PG8_WAIT_L(8); PG8_BAR; PG8_WAIT_L(0); PG8_MMA(0, 0, At, B0); PG8_BAR; PG8_SCHED;
            PG8_LDB(B1, 1, 1); PG8_STAGE(PG8_SB(1, 0), b3, voffB);
            PG8_BAR; PG8_WAIT_L(0); PG8_MMA(0, 1, At, B1); PG8_BAR;
            PG8_LDA(At, 1, 1); PG8_STAGE(PG8_SA(1, 0), a3, voffA);
            PG8_BAR; PG8_WAIT_L(0); PG8_MMA(1, 0, At, B0); PG8_BAR; PG8_SCHED;
            PG8_STAGE(PG8_SB(1, 1), b3 + hstep, voffB);
            PG8_WAIT_V(6); PG8_BAR; PG8_MMA(1, 1, At, B1); PG8_BAR;
            }
        }
        if constexpr (ALIGN_EPI) { if (wr == 0) PG8_BAR; }
        if constexpr (!Epi::AFTER_DRAIN) { E(acc, cur, wr, wc, fr, fq); S.done(cur); }
        if (!has_next) break;
#pragma unroll
        for (int a = 0; a < 2; ++a)
#pragma unroll
            for (int b = 0; b < 2; ++b)
#pragma unroll
                for (int m = 0; m < 4; ++m)
#pragma unroll
                    for (int n = 0; n < 2; ++n) acc[a][b][m][n] = (f32x4){0.f, 0.f, 0.f, 0.f};
        cur = nxt; cA = nA; cB = nB; ++ui;
        if constexpr (ALIGN_EPI) { if (wr == 1) PG8_BAR; }
    }
    PG8_WAIT_V(0);
    if constexpr (!ALIGN_EPI) { if (wr == 0) PG8_BAR; }
    PG8_BAR;
    if constexpr (Epi::AFTER_DRAIN) { E.fused(acc, cur, wr, wc, fr, fq, lds, wid, lane); S.done(cur); }
#undef PG8_SA
#undef PG8_SB
#undef PG8_STAGE
#undef PG8_LDA
#undef PG8_LDB
#undef PG8_MMA
#undef PG8_WAIT_V
#undef PG8_WAIT_L
#undef PG8_BAR
#undef PG8_SCHED
}
}

#define DI __device__ __forceinline__
#define LAS __attribute__((address_space(3)))
typedef unsigned short bf16_t;
typedef short bf16x8 __attribute__((ext_vector_type(8)));
typedef float f32x4 __attribute__((ext_vector_type(4)));
typedef float f32x16 __attribute__((ext_vector_type(16)));
typedef unsigned u32x4 __attribute__((ext_vector_type(4)));
typedef unsigned u32x2 __attribute__((ext_vector_type(2)));
constexpr int DM = 1024, NB = 8, SEQ = 4096, NTOK = NB * SEQ, INW = 4096, QKGW = 3072;
constexpr float EPS = 1e-6f, LOG2E = 1.4426950408889634f;
constexpr size_t MiB = 1u << 20;
constexpr size_t WS_CTL = 0, CTL_BYTES = 4096;
constexpr size_t WS_WIN = 2 * MiB, WS_WOUT = 18 * MiB, WS_CS = 22 * MiB, WS_H = 32 * MiB, WS_QKG = 96 * MiB, WS_VT = 288 * MiB, WS_YMIX = 352 * MiB;
constexpr size_t WS_Y = WS_QKG;
constexpr int LDS_BYTES = 135168;
constexpr int NITEM_C = 4096, NITEM_B = 6144, NITEM_A = 6144, NITEMS = NITEM_C + NITEM_B + NITEM_A;
constexpr int TABP = 520;

struct Args {
    const float* x; const int* pos; const float* w_in; const float* w_out; const float* pre_g; const float* post_g; const float* rel;
    const float* lq1; const float* lk1; const float* lq2; const float* lk2; const float* subln;
    float* out; unsigned char* ws;
    float inv_freq[16];
    float lam_init[2];
    float oml[2];
};

DI int opq_s(int v) { asm volatile("" : "+s"(v)); return v; }
DI int lane_id() { int l; asm volatile("v_mbcnt_lo_u32_b32 %0, -1, 0\n\tv_mbcnt_hi_u32_b32 %0, -1, %0" : "=v"(l)); return l; }
DI float wave_sum(float v) {
#pragma unroll
    for (int o = 1; o < 64; o <<= 1) v += __shfl_xor(v, o);
    return v;
}
DI float swap_sum(float v) { auto rr = __builtin_amdgcn_permlane32_swap(__float_as_uint(v), __float_as_uint(v), false, false); return __uint_as_float(rr[0]) + __uint_as_float(rr[1]); }
DI float swap_max(float v) { auto rr = __builtin_amdgcn_permlane32_swap(__float_as_uint(v), __float_as_uint(v), false, false); return fmaxf(__uint_as_float(rr[0]), __uint_as_float(rr[1])); }
DI float ex2(float v) { return __builtin_amdgcn_exp2f(v); }
DI float lg2(float v) { return __builtin_amdgcn_logf(v); }
DI bf16x8 ld16(const bf16_t* p) { return *(const bf16x8*)p; }
#define MFMA32(a, b, c) __builtin_amdgcn_mfma_f32_32x32x16_bf16((a), (b), (c), 0, 0, 0)
DI bf16x8 pack8(float a0, float a1, float a2, float a3, float a4, float a5, float a6, float a7) {
    u32x4 w; w.x = pg8::cvt_pk_bf16(a0, a1); w.y = pg8::cvt_pk_bf16(a2, a3); w.z = pg8::cvt_pk_bf16(a4, a5); w.w = pg8::cvt_pk_bf16(a6, a7);
    return __builtin_bit_cast(bf16x8, w);
}

DI void transpose_item(const float* W, int K, int N, bf16_t* WT, int k0, int n0, int dst_row0, LAS float* scr, int lane) {
#pragma unroll 8
    for (int i = 0; i < 32; ++i) { const int kk = 2 * i + (lane >> 5); scr[kk * 33 + (lane & 31)] = W[(size_t)(k0 + kk) * N + n0 + (lane & 31)]; }
    asm volatile("s_waitcnt lgkmcnt(0)" ::: "memory");
    const int c = lane & 7;
#pragma unroll
    for (int j = 0; j < 4; ++j) { const int n = (lane >> 3) + 8 * j; const LAS float* s = scr + (8 * c) * 33 + n;
        u32x4 o; o.x = pg8::cvt_pk_bf16(s[0 * 33], s[1 * 33]); o.y = pg8::cvt_pk_bf16(s[2 * 33], s[3 * 33]); o.z = pg8::cvt_pk_bf16(s[4 * 33], s[5 * 33]); o.w = pg8::cvt_pk_bf16(s[6 * 33], s[7 * 33]);
        *(u32x4*)(WT + (size_t)(dst_row0 + n) * K + k0 + 8 * c) = o; }
    asm volatile("s_waitcnt lgkmcnt(0)" ::: "memory");
}
DI int win_dest(int n0) {
    int grp_off, T, rem;
    if (n0 < 1536) { T = n0 / 384; rem = n0 % 384; grp_off = 0; }
    else if (n0 < 3072) { const int n1 = n0 - 1536; T = n1 / 384; rem = n1 % 384; grp_off = 384; }
    else { const int n1 = n0 - 3072; T = n1 / 256; rem = n1 % 256; grp_off = 768; }
    const int tm = (T == 0) ? 0 : (T == 1) ? 1 : (T == 2) ? 3 : 2;
    return tm * 1024 + grp_off + rem;
}
DI void prenorm_row(const float* xrow, const float* g, bf16_t* hrow, int lane) {
    f32x4 v[4]; float s = 0.f;
#pragma unroll
    for (int j = 0; j < 4; ++j) { v[j] = ((const f32x4*)xrow)[lane + 64 * j]; s += (v[j][0] * v[j][0] + v[j][1] * v[j][1]) + (v[j][2] * v[j][2] + v[j][3] * v[j][3]); }
    const float r = 1.f / sqrtf(wave_sum(s) * (1.f / DM) + EPS);
#pragma unroll
    for (int j = 0; j < 4; ++j) { const f32x4 gg = ((const f32x4*)g)[lane + 64 * j];
        u32x2 o; o.x = pg8::cvt_pk_bf16(v[j][0] * r * gg[0], v[j][1] * r * gg[1]); o.y = pg8::cvt_pk_bf16(v[j][2] * r * gg[2], v[j][3] * r * gg[3]);
        ((u32x2*)hrow)[lane + 64 * j] = o; }
}

DI int sigma32(int m) { return (m & 0x13) | ((m & 4) << 1) | ((m & 8) >> 1); }

DI void gate_store(const f32x16& o0, const f32x16& o1, const bf16_t* gp, bf16_t* yp) {
#pragma unroll
    for (int db = 0; db < 2; ++db)
#pragma unroll
        for (int gq = 0; gq < 4; ++gq) { const int off = 32 * db + 8 * gq;
            const u32x2 gw = *(const u32x2*)(gp + off);
            const float g0 = __uint_as_float(gw.x << 16), g1 = __uint_as_float(gw.x & 0xffff0000u), g2 = __uint_as_float(gw.y << 16), g3 = __uint_as_float(gw.y & 0xffff0000u);
            const float v0 = db ? o1[4 * gq + 0] : o0[4 * gq + 0], v1 = db ? o1[4 * gq + 1] : o0[4 * gq + 1], v2 = db ? o1[4 * gq + 2] : o0[4 * gq + 2], v3 = db ? o1[4 * gq + 3] : o0[4 * gq + 3];
            const float y0 = v0 * g0 * __builtin_amdgcn_rcpf(1.f + ex2(-g0 * LOG2E)), y1 = v1 * g1 * __builtin_amdgcn_rcpf(1.f + ex2(-g1 * LOG2E));
            const float y2 = v2 * g2 * __builtin_amdgcn_rcpf(1.f + ex2(-g2 * LOG2E)), y3 = v3 * g3 * __builtin_amdgcn_rcpf(1.f + ex2(-g3 * LOG2E));
            u32x2 w; w.x = pg8::cvt_pk_bf16(y0, y1); w.y = pg8::cvt_pk_bf16(y2, y3); *(u32x2*)(yp + off) = w; }
}

#define LOADK64(kf, kptr) do { _Pragma("unroll") for (int blk_ = 0; blk_ < 2; ++blk_) _Pragma("unroll") for (int d0_ = 0; d0_ < 4; ++d0_) kf[blk_][d0_] = ld16((kptr) + (size_t)(32 * blk_) * QKGW + 16 * d0_); } while (0)
#define LOADV64(vf, vptr) do { _Pragma("unroll") for (int db_ = 0; db_ < 2; ++db_) _Pragma("unroll") for (int ks_ = 0; ks_ < 4; ++ks_) vf[db_][ks_] = ld16((vptr) + (size_t)(32 * db_) * NTOK + 16 * ks_); } while (0)

DI void attn_A(const bf16_t* QKG, const bf16_t* Vt, bf16_t* Y, int b, int u, int qb32, int lane) {
    const int r32 = lane & 31, hi = lane >> 5; const int t0 = qb32 * 32, t = t0 + r32; const size_t tokbase = (size_t)b * SEQ;
    const bf16_t* qp = QKG + (tokbase + t) * QKGW + u * 64 + hi * 8;
    bf16x8 qf[4];
#pragma unroll
    for (int d0 = 0; d0 < 4; ++d0) qf[d0] = ld16(qp + 16 * d0);
    const bf16_t* kbase = QKG + (tokbase + sigma32(r32)) * QKGW + 1024 + u * 64 + hi * 8;
    const bf16_t* vbase = Vt + (size_t)(u * 64 + r32) * NTOK + tokbase + hi * 8;
    f32x16 o0 = {}, o1 = {};
    float R = 0.f;
    const int kt_diag = t0 >> 6;
    bf16x8 kf[2][4];
    LOADK64(kf, kbase + (size_t)(kt_diag * 64) * QKGW);
    for (int kt = kt_diag; kt >= 0; --kt) {
        const int key0 = kt * 64;
        bf16x8 vf[2][4];
        LOADV64(vf, vbase + key0);
        f32x16 p[2]; p[0] = f32x16{}; p[1] = f32x16{};
#pragma unroll
        for (int d0 = 0; d0 < 4; ++d0) { p[0] = MFMA32(kf[0][d0], qf[d0], p[0]); p[1] = MFMA32(kf[1][d0], qf[d0], p[1]); }
        if (kt > 0) LOADK64(kf, kbase + (size_t)(key0 - 64) * QKGW);
        const bool diag = (kt == kt_diag);
        float sps[4][8], g[4], T[4];
#pragma unroll
        for (int a = 0; a < 4; ++a) { float gs = 0.f;
#pragma unroll
            for (int i = 0; i < 8; ++i) { const float z = p[a >> 1][8 * (a & 1) + i];
                float sp = fmaxf(z, 0.f) + lg2(1.f + ex2(-fabsf(z)));
                if (diag) { const int kidx = key0 + 16 * a + 8 * hi + i; if (kidx >= t) sp = 0.f; }
                sps[a][i] = sp; p[a >> 1][8 * (a & 1) + i] = z - sp; gs += sp; }
            g[a] = gs; T[a] = swap_sum(gs); }
        bf16x8 pf[4];
        float later = 0.f;
#pragma unroll
        for (int a = 3; a >= 0; --a) {
            float e = later + (hi == 0 ? (T[a] - g[a]) : 0.f);
            float w[8];
#pragma unroll
            for (int i = 7; i >= 0; --i) { float wv = ex2(p[a >> 1][8 * (a & 1) + i] - e + R);
                if (diag) { const int kidx = key0 + 16 * a + 8 * hi + i; if (kidx >= t) wv = 0.f; }
                w[i] = wv; e += sps[a][i]; }
            pf[a] = pack8(w[0], w[1], w[2], w[3], w[4], w[5], w[6], w[7]);
            later += T[a];
        }
        R -= later;
#pragma unroll
        for (int ks = 0; ks < 4; ++ks) { o0 = MFMA32(vf[0][ks], pf[ks], o0); o1 = MFMA32(vf[1][ks], pf[ks], o1); }
        if (__all(R < -160.f)) break;
    }
    gate_store(o0, o1, QKG + (tokbase + t) * QKGW + 2048 + u * 64 + 4 * hi, Y + (tokbase + t) * DM + u * 64 + 4 * hi);
}

DI void attn_B(const bf16_t* QKG, const bf16_t* Vt, bf16_t* Y, const LAS float* tab, int b, int u, int qb32, int lane) {
    const int r32 = lane & 31, hi = lane >> 5; const int t0 = qb32 * 32, t = t0 + r32; const size_t tokbase = (size_t)b * SEQ;
    const bf16_t* qp = QKG + (tokbase + t) * QKGW + u * 64 + hi * 8;
    bf16x8 qf[4];
#pragma unroll
    for (int d0 = 0; d0 < 4; ++d0) qf[d0] = ld16(qp + 16 * d0);
    const bf16_t* kbase = QKG + (tokbase + sigma32(r32)) * QKGW + 1024 + u * 64 + hi * 8;
    const bf16_t* vbase = Vt + (size_t)(u * 64 + r32) * NTOK + tokbase + hi * 8;
    const LAS float* tb = tab + (u - 6) * TABP;
    f32x16 o0 = {}, o1 = {};
    float m = -1e30f, l = 0.f;
    const int c = t0 >> 6; const int kt_lo = (c - 8 > 0) ? (c - 8) : 0;
    bf16x8 kf[2][4];
    LOADK64(kf, kbase + (size_t)(kt_lo * 64) * QKGW);
    const float bias_far = tb[512];
    for (int kt = kt_lo; kt <= c; ++kt) {
        const int key0 = kt * 64;
        bf16x8 vf[2][4];
        LOADV64(vf, vbase + key0);
        f32x16 p[2]; p[0] = f32x16{}; p[1] = f32x16{};
#pragma unroll
        for (int d0 = 0; d0 < 4; ++d0) { p[0] = MFMA32(kf[0][d0], qf[d0], p[0]); p[1] = MFMA32(kf[1][d0], qf[d0], p[1]); }
        if (kt < c) LOADK64(kf, kbase + (size_t)(key0 + 64) * QKGW);
        if (c - kt >= 5) {
#pragma unroll
            for (int r = 0; r < 16; ++r) { p[0][r] += bias_far; p[1][r] += bias_far; }
        } else {
#pragma unroll
            for (int a = 0; a < 4; ++a)
#pragma unroll
                for (int i = 0; i < 8; ++i) { const int kidx = key0 + 16 * a + 8 * hi + i; int rel = t - kidx; rel = rel < -256 ? -256 : (rel > 256 ? 256 : rel);
                    p[a >> 1][8 * (a & 1) + i] += tb[rel + 256]; }
        }
        float tm = p[0][0];
#pragma unroll
        for (int r = 1; r < 16; ++r) tm = fmaxf(tm, p[0][r]);
#pragma unroll
        for (int r = 0; r < 16; ++r) tm = fmaxf(tm, p[1][r]);
        tm = swap_max(tm);
        const float mn = fmaxf(m, tm), alpha = ex2(m - mn); m = mn;
        float ls = 0.f;
#pragma unroll
        for (int r = 0; r < 16; ++r) { p[0][r] = ex2(p[0][r] - mn); p[1][r] = ex2(p[1][r] - mn); ls += p[0][r] + p[1][r]; }
        l = l * alpha + ls;
#pragma unroll
        for (int r = 0; r < 16; ++r) { o0[r] *= alpha; o1[r] *= alpha; }
        bf16x8 pf[4];
#pragma unroll
        for (int a = 0; a < 4; ++a) { const int bb = 8 * (a & 1); const f32x16& pp = p[a >> 1];
            pf[a] = pack8(pp[bb + 0], pp[bb + 1], pp[bb + 2], pp[bb + 3], pp[bb + 4], pp[bb + 5], pp[bb + 6], pp[bb + 7]); }
#pragma unroll
        for (int ks = 0; ks < 4; ++ks) { o0 = MFMA32(vf[0][ks], pf[ks], o0); o1 = MFMA32(vf[1][ks], pf[ks], o1); }
    }
    const float rl = 1.f / swap_sum(l);
#pragma unroll
    for (int r = 0; r < 16; ++r) { o0[r] *= rl; o1[r] *= rl; }
    gate_store(o0, o1, QKG + (tokbase + t) * QKGW + 2048 + u * 64 + 4 * hi, Y + (tokbase + t) * DM + u * 64 + 4 * hi);
}

DI void attn_C(const bf16_t* QKG, const bf16_t* Vt, bf16_t* Y, const float* subg, float lam, float oml, int b, int u, int qb32, int lane) {
    const int r32 = lane & 31, hi = lane >> 5; const int t0 = qb32 * 32, t = t0 + r32; const size_t tokbase = (size_t)b * SEQ;
    const bf16_t* qp = QKG + (tokbase + t) * QKGW + u * 64 + hi * 8;
    bf16x8 qf[2][2];
#pragma unroll
    for (int cc = 0; cc < 2; ++cc)
#pragma unroll
        for (int d0 = 0; d0 < 2; ++d0) qf[cc][d0] = ld16(qp + 32 * cc + 16 * d0);
    const bf16_t* kbase = QKG + (tokbase + sigma32(r32)) * QKGW + 1024 + u * 64 + hi * 8;
    const bf16_t* vbase = Vt + (size_t)(u * 64 + r32) * NTOK + tokbase + hi * 8;
    f32x16 oa0 = {}, oa1 = {}, ob0 = {}, ob1 = {};
    float m1 = -1e30f, l1 = 0.f, m2 = -1e30f, l2 = 0.f;
    const int c = t0 >> 6;
    bf16x8 kf[2][4];
    LOADK64(kf, kbase);
#define SOFTMAX_PV(P, M, L, OA, OB) do { \
            float tm = P[0][0]; \
            _Pragma("unroll") for (int r = 1; r < 16; ++r) tm = fmaxf(tm, P[0][r]); \
            _Pragma("unroll") for (int r = 0; r < 16; ++r) tm = fmaxf(tm, P[1][r]); \
            tm = swap_max(tm); \
            const float mn = fmaxf(M, tm), alpha = ex2(M - mn); M = mn; \
            float ls = 0.f; \
            _Pragma("unroll") for (int r = 0; r < 16; ++r) { P[0][r] = ex2(P[0][r] - mn); P[1][r] = ex2(P[1][r] - mn); ls += P[0][r] + P[1][r]; } \
            L = L * alpha + ls; \
            _Pragma("unroll") for (int r = 0; r < 16; ++r) { OA[r] *= alpha; OB[r] *= alpha; } \
            bf16x8 pf[4]; \
            _Pragma("unroll") for (int a = 0; a < 4; ++a) { const int bb = 8 * (a & 1); const f32x16& pp = P[a >> 1]; \
                pf[a] = pack8(pp[bb + 0], pp[bb + 1], pp[bb + 2], pp[bb + 3], pp[bb + 4], pp[bb + 5], pp[bb + 6], pp[bb + 7]); } \
            _Pragma("unroll") for (int ks = 0; ks < 4; ++ks) { OA = MFMA32(vf[0][ks], pf[ks], OA); OB = MFMA32(vf[1][ks], pf[ks], OB); } \
        } while (0)
    for (int kt = 0; kt <= c; ++kt) {
        const int key0 = kt * 64;
        bf16x8 vf[2][4];
        LOADV64(vf, vbase + key0);
        f32x16 p[2]; p[0] = f32x16{}; p[1] = f32x16{};
#pragma unroll
        for (int d0 = 0; d0 < 2; ++d0) { p[0] = MFMA32(kf[0][d0], qf[0][d0], p[0]); p[1] = MFMA32(kf[1][d0], qf[0][d0], p[1]); }
        SOFTMAX_PV(p, m1, l1, oa0, oa1);
        __builtin_amdgcn_sched_barrier(0);
        p[0] = f32x16{}; p[1] = f32x16{};
#pragma unroll
        for (int d0 = 0; d0 < 2; ++d0) { p[0] = MFMA32(kf[0][2 + d0], qf[1][d0], p[0]); p[1] = MFMA32(kf[1][2 + d0], qf[1][d0], p[1]); }
        if (kt < c) LOADK64(kf, kbase + (size_t)(key0 + 64) * QKGW);
        SOFTMAX_PV(p, m2, l2, ob0, ob1);
    }
#undef SOFTMAX_PV
    const float r1 = 1.f / swap_sum(l1), r2 = lam / swap_sum(l2);
    float ss = 0.f;
#pragma unroll
    for (int r = 0; r < 16; ++r) { oa0[r] = oa0[r] * r1 - ob0[r] * r2; oa1[r] = oa1[r] * r1 - ob1[r] * r2; ss += oa0[r] * oa0[r] + oa1[r] * oa1[r]; }
    ss = swap_sum(ss);
    const float rn = (1.f / sqrtf(ss * (1.f / 64.f) + EPS)) * oml;
#pragma unroll
    for (int r = 0; r < 16; ++r) { const int d = 8 * (r >> 2) + 4 * hi + (r & 3); oa0[r] *= rn * subg[d]; oa1[r] *= rn * subg[32 + d]; }
    gate_store(oa0, oa1, QKG + (tokbase + t) * QKGW + 2048 + u * 64 + 4 * hi, Y + (tokbase + t) * DM + u * 64 + 4 * hi);
}

__global__ void __launch_bounds__(512) fwd_mega(Args a) {
    extern __shared__ __attribute__((aligned(16))) unsigned char lds_raw[];
    cg::grid_group grid = cg::this_grid();
    LAS unsigned char* lds = (LAS unsigned char*)lds_raw;
    const int wave = __builtin_amdgcn_readfirstlane((int)threadIdx.x >> 6);
    const int G = gridDim.x, gw = blockIdx.x * 8 + wave, NGW = G * 8;
    unsigned char* ws = a.ws;
    unsigned* ctl = (unsigned*)(ws + WS_CTL);
    bf16_t* WtIn = (bf16_t*)(ws + WS_WIN); bf16_t* WtOut = (bf16_t*)(ws + WS_WOUT); float* CS = (float*)(ws + WS_CS);
    bf16_t* H = (bf16_t*)(ws + WS_H); bf16_t* QKG = (bf16_t*)(ws + WS_QKG); bf16_t* Vt = (bf16_t*)(ws + WS_VT); bf16_t* YM = (bf16_t*)(ws + WS_YMIX); float* Yf = (float*)(ws + WS_Y);

    {
        const int lane = lane_id(), tid = wave * 64 + lane;
        LAS float* scr = (LAS float*)(lds + wave * 16384);
        for (int it = gw; it < 5120; it += NGW) {
            const int layer = it / 2560, r = it % 2560;
            if (r < 2048) { const int kb = r / 128, nb = r % 128; transpose_item(a.w_in + (size_t)layer * DM * INW, DM, INW, WtIn + (size_t)layer * INW * DM, 64 * kb, 32 * nb, win_dest(32 * nb), scr, lane); }
            else { const int r2 = r - 2048, kb = r2 / 32, nb = r2 % 32; transpose_item(a.w_out + (size_t)layer * DM * DM, DM, DM, WtOut + (size_t)layer * DM * DM, 64 * kb, 32 * nb, 32 * nb, scr, lane); }
        }
        for (int e = blockIdx.x * 512 + tid; e < NTOK * 16; e += G * 512) {
            const int tok = e >> 4, i = e & 15;
            const float ang = (float)a.pos[tok] * a.inv_freq[i];
            const double tt = (double)ang * 0.15915494309189535; const float fr = (float)(tt - rint(tt));
            CS[2 * e] = __builtin_amdgcn_cosf(fr); CS[2 * e + 1] = __builtin_amdgcn_sinf(fr);
        }
        for (int row = gw; row < NTOK; row += NGW) prenorm_row(a.x + (size_t)row * DM, a.pre_g, H + (size_t)row * DM, lane);
    }
    grid.sync();

    for (int layer = 0; layer < 2; ++layer) {
        {
            const bf16_t* W = WtIn + (size_t)layer * INW * DM;
            { pg8::Gemm g{H, W, NTOK, QKGW, DM}; pg8::StaticOrder S; S.init(NTOK, QKGW, opq_s(G), opq_s((int)blockIdx.x));
              pg8::EpiQKG E{QKG, CS, 0.125f * LOG2E, 0.17677669529663687f * LOG2E};
              pg8::gemm_phase<pg8::EpiQKG, pg8::StaticOrder, true, true>(lds, g, S, E, wave); }
            { pg8::Gemm g{W + (size_t)QKGW * DM, H, DM, NTOK, DM}; pg8::StaticOrder S; S.init(DM, NTOK, opq_s(G), opq_s((int)blockIdx.x));
              pg8::EpiPlain E{Vt, NTOK};
              pg8::gemm_phase<pg8::EpiPlain, pg8::StaticOrder, true, true>(lds, g, S, E, wave); }
        }
        grid.sync();
        {
            const int lane = lane_id(), tid = wave * 64 + lane;
            LAS float* tab = (LAS float*)lds;
            for (int i = tid; i < 6 * 513; i += 512) tab[(i / 513) * TABP + (i % 513)] = a.rel[layer * 6 * 513 + i] * LOG2E;
            __syncthreads();
            float lam;
            { const float v1 = (lane < 32) ? a.lq1[layer * 32 + lane] * a.lk1[layer * 32 + lane] : 0.f, v2 = (lane < 32) ? a.lq2[layer * 32 + lane] * a.lk2[layer * 32 + lane] : 0.f;
              lam = expf(wave_sum(v1)) - expf(wave_sum(v2)) + a.lam_init[layer];
              lam = __uint_as_float((unsigned)__builtin_amdgcn_readfirstlane((int)__float_as_uint(lam))); }
            unsigned* ctr = ctl + 64 * (1 + layer);
            for (;;) {
                unsigned it = 0; if (lane == 0) it = atomicAdd(ctr, 1u);
                it = (unsigned)__builtin_amdgcn_readfirstlane((int)it);
                if (it >= (unsigned)NITEMS) break;
                const int ln = lane_id();
                if (it < NITEM_C) { const int gI = it >> 8, j = it & 255, cg_ = 15 - gI, bh = j >> 3, w = j & 7;
                    attn_C(QKG, Vt, YM, a.subln + layer * 64, lam, a.oml[layer], bh >> 2, 12 + (bh & 3), cg_ * 8 + w, ln); }
                else if (it < NITEM_C + NITEM_B) { const int j = it - NITEM_C, bh = j >> 7, qb = j & 127;
                    attn_B(QKG, Vt, YM, tab, bh / 6, 6 + bh % 6, qb, ln); }
                else { const int j = it - NITEM_C - NITEM_B, bh = j >> 7, qb = j & 127;
                    attn_A(QKG, Vt, YM, bh / 6, bh % 6, qb, ln); }
            }
        }
        grid.sync();
        {
            pg8::Gemm g{YM, WtOut + (size_t)layer * DM * DM, NTOK, DM, DM}; pg8::StaticOrder S; S.init(NTOK, DM, opq_s(G), opq_s((int)blockIdx.x));
            pg8::EpiF32 E{Yf, DM};
            pg8::gemm_phase<pg8::EpiF32, pg8::StaticOrder, true, true>(lds, g, S, E, wave);
        }
        grid.sync();
        {
            const float* xprev = (layer == 0) ? a.x : a.out;
            const float* pg = a.post_g + layer * DM;
            const int lane4 = lane_id(), lane = lane4;
            for (int row = gw; row < NTOK; row += NGW) {
                f32x4 y[4], xv[4]; float s = 0.f;
#pragma unroll
                for (int j = 0; j < 4; ++j) { y[j] = ((const f32x4*)(Yf + (size_t)row * DM))[lane4 + 64 * j]; xv[j] = ((const f32x4*)(xprev + (size_t)row * DM))[lane4 + 64 * j];
                    s += (y[j][0] * y[j][0] + y[j][1] * y[j][1]) + (y[j][2] * y[j][2] + y[j][3] * y[j][3]); }
                const float r = 1.f / sqrtf(wave_sum(s) * (1.f / DM) + EPS);
                float s2 = 0.f;
#pragma unroll
                for (int j = 0; j < 4; ++j) { const f32x4 gg = ((const f32x4*)pg)[lane4 + 64 * j]; xv[j] = xv[j] + y[j] * r * gg;
                    ((f32x4*)(a.out + (size_t)row * DM))[lane4 + 64 * j] = xv[j];
                    s2 += (xv[j][0] * xv[j][0] + xv[j][1] * xv[j][1]) + (xv[j][2] * xv[j][2] + xv[j][3] * xv[j][3]); }
                if (layer == 0) {
                    const float r2 = 1.f / sqrtf(wave_sum(s2) * (1.f / DM) + EPS);
#pragma unroll
                    for (int j = 0; j < 4; ++j) { const f32x4 gg = ((const f32x4*)(a.pre_g + DM))[lane4 + 64 * j];
                        u32x2 o; o.x = pg8::cvt_pk_bf16(xv[j][0] * r2 * gg[0], xv[j][1] * r2 * gg[1]); o.y = pg8::cvt_pk_bf16(xv[j][2] * r2 * gg[2], xv[j][3] * r2 * gg[3]);
                        ((u32x2*)(H + (size_t)row * DM))[lane4 + 64 * j] = o; }
                }
            }
        }
        if (layer == 0) grid.sync();
    }
}

extern "C" void kernel_launch(void* const* d_in, const int* in_sizes, int n_in, void* d_out, int out_size, void* d_ws, size_t ws_size, hipStream_t stream) {
    static int grid_blocks = 0;
    if (!grid_blocks) {
        int dev = 0, cus = 0, per_cu = 0;
        hipGetDevice(&dev);
        hipDeviceGetAttribute(&cus, hipDeviceAttributeMultiprocessorCount, dev);
        if (hipFuncSetAttribute((const void*)fwd_mega, hipFuncAttributeMaxDynamicSharedMemorySize, LDS_BYTES) != hipSuccess) fprintf(stderr, "hipFuncSetAttribute failed\n");
        if (hipOccupancyMaxActiveBlocksPerMultiprocessor(&per_cu, (const void*)fwd_mega, 512, LDS_BYTES) != hipSuccess || per_cu < 1) { fprintf(stderr, "occupancy query: %d\n", per_cu); per_cu = 1; }
        (void)hipGetLastError();
        grid_blocks = cus * per_cu;
    }
    hipMemsetAsync((char*)d_ws + WS_CTL, 0, CTL_BYTES, stream);
    Args a{};
    a.x = (const float*)d_in[0]; a.pos = (const int*)d_in[1]; a.w_in = (const float*)d_in[2]; a.w_out = (const float*)d_in[3];
    a.pre_g = (const float*)d_in[4]; a.post_g = (const float*)d_in[5]; a.rel = (const float*)d_in[6];
    a.lq1 = (const float*)d_in[7]; a.lk1 = (const float*)d_in[8]; a.lq2 = (const float*)d_in[9]; a.lk2 = (const float*)d_in[10]; a.subln = (const float*)d_in[11];
    a.out = (float*)d_out; a.ws = (unsigned char*)d_ws;
    for (int i = 0; i < 16; ++i) a.inv_freq[i] = powf(10000.0f, -(float)i / 16.0f);
    for (int l = 0; l < 2; ++l) { a.lam_init[l] = (float)(0.8 - 0.6 * exp(-0.3 * (double)l)); a.oml[l] = 1.0f - a.lam_init[l]; }
    void* args[] = {&a};
    hipError_t e = hipLaunchCooperativeKernel((const void*)fwd_mega, dim3(grid_blocks), dim3(512), args, LDS_BYTES, stream);
    if (e != hipSuccess) fprintf(stderr, "cooperative launch failed: %s (grid %d)\n", hipGetErrorString(e), grid_blocks);
}
```

```cpp
#include <hip/hip_runtime.h>
#include <hip/hip_cooperative_groups.h>
#include <cstdio>
#include <cstdint>
#include <cmath>
namespace cg = cooperative_groups;
namespace pg8 {
#define PG8_LAS __attribute__((address_space(3)))
typedef unsigned short bf16_t;
typedef short bf16x8 __attribute__((ext_vector_type(8)));
typedef float f32x4 __attribute__((ext_vector_type(4)));
typedef unsigned u32x4 __attribute__((ext_vector_type(4)));
constexpr int BM = 256, BK = 64, HALF = 128, HTB = HALF * BK * 2  , STAGE_BYTES = 8 * HTB, NXCD = 8, WGM = 8;

__host__ __device__ __forceinline__ int lds_byte(int r, int c) { const int st = (r >> 4) * 2 + (c >> 5), rr = r & 15, cc = c & 31, ob = rr * 64 + cc * 2; return st * 1024 + (ob ^ (((ob >> 9) & 1) << 5)); }
__host__ __device__ __forceinline__ void stage_rc(int b, int& R, int& C) { const int st = b / 1024, sb = b % 1024, swz = sb ^ (((sb >> 9) & 1) << 5); R = (st >> 1) * 16 + swz / 64; C = (st & 1) * 32 + (swz % 64) / 2; }
__host__ __device__ __forceinline__ int perm32(int rho) { const int n = rho >> 4, i = rho & 15; return 8 * (i >> 2) + 4 * n + (i & 3); }

struct Unit { int pm, pn; };
struct Gemm { const bf16_t* A; const bf16_t* Bt; int M, N, K; };

struct StaticOrder {
    int nM, nN, nwg, G, c;
    __host__ __device__ void init(int M, int N, int G_, int c_) { nM = M / BM; nN = N / BM; nwg = nM * nN; G = G_; c = c_; }
    __host__ __device__ bool next(int i, Unit& u) const {
        const long L = (long)i * G + c; if (L >= nwg) return false;
        int wgid = (int)L; { const int q = nwg / NXCD, r = nwg % NXCD, xcd = wgid % NXCD, off = wgid / NXCD; wgid = (xcd < r ? xcd * (q + 1) : r * (q + 1) + (xcd - r) * q) + off; }
        const int nig = WGM * nN, gid = wgid / nig, fm = gid * WGM, gsz = (nM - fm) < WGM ? (nM - fm) : WGM;
        u.pm = fm + ((wgid % nig) % gsz); u.pn = (wgid % nig) / gsz; return true;
    }
    __device__ __forceinline__ void a_ready(const Unit&) const {}
    __device__ __forceinline__ void done(const Unit&) const {}
};


typedef float f32x2 __attribute__((ext_vector_type(2)));
typedef __bf16 bf16x2_t __attribute__((ext_vector_type(2)));
__device__ __forceinline__ unsigned cvt_pk_bf16(float lo, float hi) { f32x2 v = {lo, hi}; bf16x2_t b = __builtin_convertvector(v, bf16x2_t); return __builtin_bit_cast(unsigned, b); }

struct EpiPlain {
    static constexpr bool PERM = true, AFTER_DRAIN = false;
    bf16_t* O; int ldc;
    __device__ __forceinline__ void operator()(const f32x4 (&acc)[2][2][4][2], const Unit& u, int wr, int wc, int fr, int fq) const {
        const int row0 = u.pm * BM + wr * 64 + fr; const int col0 = u.pn * BM + wc * 32 + 8 * fq;
#pragma unroll
        for (int ai = 0; ai < 2; ++ai)
#pragma unroll
            for (int m = 0; m < 4; ++m) { bf16_t* rowp = O + (size_t)(row0 + ai * HALF + m * 16) * ldc + col0;
#pragma unroll
                for (int bj = 0; bj < 2; ++bj) { const f32x4 v0 = acc[ai][bj][m][0], v1 = acc[ai][bj][m][1];
                    u32x4 w; w.x = cvt_pk_bf16(v0[0], v0[1]); w.y = cvt_pk_bf16(v0[2], v0[3]); w.z = cvt_pk_bf16(v1[0], v1[1]); w.w = cvt_pk_bf16(v1[2], v1[3]);
                    *(u32x4*)(rowp + bj * HALF) = w; } }
    }
};
struct EpiQKG {
    static constexpr bool PERM = true, AFTER_DRAIN = false;
    bf16_t* O; const float* cs; float qsc_ab, qsc_c;
    __device__ __forceinline__ void operator()(const f32x4 (&acc)[2][2][4][2], const Unit& u, int wr, int wc, int fr, int fq) const {
        const int row0 = u.pm * BM + wr * 64 + fr; const int col0 = u.pn * BM + wc * 32 + 8 * fq;
        const int sub = u.pn & 3, tm = u.pn >> 2;
        const bool rot = (tm < 2) && (sub == 3);
        float sc = 1.f; if (tm == 0) sc = (sub == 3) ? qsc_c : qsc_ab;
        const float sgn = (fq < 2) ? -1.f : 1.f;
#pragma unroll
        for (int ai = 0; ai < 2; ++ai)
#pragma unroll
            for (int m = 0; m < 4; ++m) { const int row = row0 + ai * HALF + m * 16; bf16_t* rowp = O + (size_t)row * 3072 + col0;
                f32x4 c0 = {1.f, 0.f, 1.f, 0.f}, c1 = c0, c2 = c0, c3 = c0;
                if (rot) { const f32x4* cp = (const f32x4*)(cs + (size_t)row * 32 + (fq & 1) * 16); c0 = cp[0]; c1 = cp[1]; c2 = cp[2]; c3 = cp[3]; }
#pragma unroll
                for (int bj = 0; bj < 2; ++bj) { f32x4 v0 = acc[ai][bj][m][0], v1 = acc[ai][bj][m][1];
                    if (rot) {
                        f32x4 p0, p1;
#pragma unroll
                        for (int j = 0; j < 4; ++j) { p0[j] = __shfl_xor(v0[j], 32); p1[j] = __shfl_xor(v1[j], 32); }
                        f32x4 o0, o1;
                        o0[0] = v0[0] * c0[0] + sgn * p0[0] * c0[1]; o0[1] = v0[1] * c0[2] + sgn * p0[1] * c0[3];
                        o0[2] = v0[2] * c1[0] + sgn * p0[2] * c1[1]; o0[3] = v0[3] * c1[2] + sgn * p0[3] * c1[3];
                        o1[0] = v1[0] * c2[0] + sgn * p1[0] * c2[1]; o1[1] = v1[1] * c2[2] + sgn * p1[1] * c2[3];
                        o1[2] = v1[2] * c3[0] + sgn * p1[2] * c3[1]; o1[3] = v1[3] * c3[2] + sgn * p1[3] * c3[3];
                        v0 = o0; v1 = o1;
                    }
                    v0 = v0 * sc; v1 = v1 * sc;
                    u32x4 w; w.x = cvt_pk_bf16(v0[0], v0[1]); w.y = cvt_pk_bf16(v0[2], v0[3]); w.z = cvt_pk_bf16(v1[0], v1[1]); w.w = cvt_pk_bf16(v1[2], v1[3]);
                    *(u32x4*)(rowp + bj * HALF) = w; } }
    }
};
struct EpiF32 {
    static constexpr bool PERM = false, AFTER_DRAIN = false;
    float* O; int ldc;
    __device__ __forceinline__ void operator()(const f32x4 (&acc)[2][2][4][2], const Unit& u, int wr, int wc, int fr, int fq) const {
        const int row0 = u.pm * BM + wr * 64 + fr; const int col0 = u.pn * BM + wc * 32 + 4 * fq;
#pragma unroll
        for (int ai = 0; ai < 2; ++ai)
#pragma unroll
            for (int m = 0; m < 4; ++m) { float* rowp = O + (size_t)(row0 + ai * HALF + m * 16) * ldc + col0;
#pragma unroll
                for (int bj = 0; bj < 2; ++bj)
#pragma unroll
                    for (int n = 0; n < 2; ++n) *(f32x4*)(rowp + bj * HALF + n * 16) = acc[ai][bj][m][n]; }
    }
};

template <class Epi, class Sched, bool ALIGN_EPI = false, bool SP2 = false>
__device__ __forceinline__ void gemm_phase(PG8_LAS unsigned char* lds, const Gemm g, const Sched& S, const Epi& E, const int wave_in) {
    int lane_; asm volatile("v_mbcnt_lo_u32_b32 %0, -1, 0\n\tv_mbcnt_hi_u32_b32 %0, -1, %0" : "=v"(lane_)); int wid_ = wave_in; asm volatile("" : "+s"(wid_)); const int wid = wid_, lane = lane_, tid = wid * 64 + lane, wr = wid >> 2, wc = wid & 3, fr = lane & 15, fq = lane >> 4;
    const int K = g.K, nt = K / BK;
    unsigned voffA[2], voffB[2];
#pragma unroll
    for (int i = 0; i < 2; ++i) { int R, C; stage_rc(tid * 16 + i * 8192, R, C); const int Rb = Epi::PERM ? ((R & ~31) + perm32(R & 31)) : R;
        voffA[i] = (unsigned)(R * K + C) * 2u; voffB[i] = (unsigned)(Rb * K + C) * 2u; }
    const size_t kstep = (size_t)(BK * 2);
    const size_t hstep = (size_t)HALF * K * 2;
    const size_t tstep = 2 * hstep;
    const unsigned ldsw = (unsigned)wid * 1024u;
    const int aoff = lds_byte(wr * 64 + fr, fq * 8), boff = lds_byte(wc * 32 + fr, fq * 8);
#define PG8_SA(b, h) (((b) * 2 + (h)) * HTB)
#define PG8_SB(b, h) ((4 + (b) * 2 + (h)) * HTB)
#define PG8_STAGE(bufoff, gbase, voff) do { _Pragma("unroll") for (int _i = 0; _i < 2; ++_i) \
        __builtin_amdgcn_global_load_lds((const unsigned*)((const char*)(gbase) + (voff)[_i]), (PG8_LAS unsigned*)(lds + (bufoff) + ldsw + _i * 8192), 16, 0, 0); } while (0)
#define PG8_LDA(dst, b, h) do { _Pragma("unroll") for (int m = 0; m < 4; ++m) _Pragma("unroll") for (int k = 0; k < 2; ++k) dst[m][k] = *(const PG8_LAS bf16x8*)(lds + PG8_SA(b, h) + aoff + m * 2048 + k * 1024); } while (0)
#define PG8_LDB(dst, b, h) do { _Pragma("unroll") for (int n = 0; n < 2; ++n) _Pragma("unroll") for (int k = 0; k < 2; ++k) dst[n][k] = *(const PG8_LAS bf16x8*)(lds + PG8_SB(b, h) + boff + n * 2048 + k * 1024); } while (0)
#define PG8_MMA(ai, bj, At, Bt) do { __builtin_amdgcn_s_setprio(1); _Pragma("unroll") for (int m = 0; m < 4; ++m) _Pragma("unroll") for (int n = 0; n < 2; ++n) _Pragma("unroll") for (int k = 0; k < 2; ++k) \
        acc[ai][bj][m][n] = __builtin_amdgcn_mfma_f32_16x16x32_bf16(Bt[n][k], At[m][k], acc[ai][bj][m][n], 0, 0, 0); __builtin_amdgcn_s_setprio(0); } while (0)
#define PG8_WAIT_V(n) asm volatile("s_waitcnt vmcnt(" #n ")" ::: "memory")
#define PG8_WAIT_L(n) asm volatile("s_waitcnt lgkmcnt(" #n ")" ::: "memory")
#define PG8_BAR __builtin_amdgcn_s_barrier()
#define PG8_SCHED __builtin_amdgcn_sched_barrier(0)
    Unit cur, nxt; int ui = 0;
    if (!S.next(0, cur)) return;
    f32x4 acc[2][2][4][2];
#pragma unroll
    for (int a = 0; a < 2; ++a)
#pragma unroll
        for (int b = 0; b < 2; ++b)
#pragma unroll
            for (int m = 0; m < 4; ++m)
#pragma unroll
                for (int n = 0; n < 2; ++n) acc[a][b][m][n] = (f32x4){0.f, 0.f, 0.f, 0.f};
    bf16x8 At[4][2], B0[2][2], B1[2][2];
    const char* cA = (const char*)g.A + (size_t)cur.pm * tstep; const char* cB = (const char*)g.Bt + (size_t)cur.pn * tstep;
    S.a_ready(cur);
    if constexpr (SP2) {
        PG8_STAGE(PG8_SB(0, 0), cB, voffB); PG8_STAGE(PG8_SB(0, 1), cB + hstep, voffB); PG8_STAGE(PG8_SA(0, 0), cA, voffA); PG8_STAGE(PG8_SA(0, 1), cA + hstep, voffA);
        if (wr == 1) PG8_BAR;
        PG8_WAIT_V(2); PG8_BAR;
        PG8_STAGE(PG8_SB(1, 0), cB + kstep, voffB); PG8_STAGE(PG8_SA(1, 0), cA + kstep, voffA); PG8_STAGE(PG8_SB(1, 1), cB + hstep + kstep, voffB);
        PG8_WAIT_V(6); PG8_BAR;
    } else {
        PG8_STAGE(PG8_SB(0, 0), cB, voffB); PG8_STAGE(PG8_SA(0, 0), cA, voffA); PG8_STAGE(PG8_SB(0, 1), cB + hstep, voffB); PG8_STAGE(PG8_SA(0, 1), cA + hstep, voffA);
        if (wr == 1) PG8_BAR;
        PG8_WAIT_V(4); PG8_BAR;
        PG8_STAGE(PG8_SB(1, 0), cB + kstep, voffB); PG8_STAGE(PG8_SA(1, 0), cA + kstep, voffA); PG8_STAGE(PG8_SB(1, 1), cB + hstep + kstep, voffB);
        PG8_WAIT_V(6); PG8_BAR;
    }
    for (;;) {
        const bool has_next = S.next(ui + 1, nxt);
        const char* nA = has_next ? (const char*)g.A + (size_t)nxt.pm * tstep : cA; const char* nB = has_next ? (const char*)g.Bt + (size_t)nxt.pn * tstep : cB;
        for (int t = 0; t < nt; t += 2) {
            const bool last = (t == nt - 2);
            const char* a1 = cA + (size_t)(t + 1) * kstep;
            const char* a2 = last ? nA : cA + (size_t)(t + 2) * kstep; const char* b2 = last ? nB : cB + (size_t)(t + 2) * kstep;
            const char* a3 = a2 + kstep; const char* b3 = b2 + kstep;
            if (last && has_next) S.a_ready(nxt);
            if constexpr (SP2) {
            PG8_LDB(B0, 0, 0); PG8_LDB(B1, 0, 1); PG8_SCHED; PG8_LDA(At, 0, 0); PG8_STAGE(PG8_SA(1, 1), a1 + hstep, voffA);
            PG8_WAIT_V(8); PG8_WAIT_L(0); PG8_BAR; PG8_MMA(0, 0, At, B0); PG8_MMA(0, 1, At, B1); PG8_BAR; PG8_SCHED;
            PG8_LDA(At, 0, 1); PG8_STAGE(PG8_SB(0, 0), b2, voffB); PG8_STAGE(PG8_SB(0, 1), b2 + hstep, voffB); PG8_STAGE(PG8_SA(0, 0), a2, voffA);
            PG8_WAIT_V(8); PG8_WAIT_L(0); PG8_BAR; PG8_MMA(1, 0, At, B0); PG8_MMA(1, 1, At, B1); PG8_BAR; PG8_SCHED;
            PG8_LDB(B0, 1, 0); PG8_LDB(B1, 1, 1); PG8_SCHED; PG8_LDA(At, 1, 0); PG8_STAGE(PG8_SA(0, 1), a2 + hstep, voffA);
            PG8_WAIT_V(8); PG8_WAIT_L(0); PG8_BAR; PG8_MMA(0, 0, At, B0); PG8_MMA(0, 1, At, B1); PG8_BAR; PG8_SCHED;
            PG8_LDA(At, 1, 1); PG8_STAGE(PG8_SB(1, 0), b3, voffB); PG8_STAGE(PG8_SB(1, 1), b3 + hstep, voffB); PG8_STAGE(PG8_SA(1, 0), a3, voffA);
            PG8_WAIT_V(8); PG8_WAIT_L(0); PG8_BAR; PG8_MMA(1, 0, At, B0); PG8_MMA(1, 1, At, B1); PG8_BAR; PG8_SCHED;
            } else {
            PG8_LDB(B0, 0, 0); PG8_SCHED; PG8_LDA(At, 0, 0); PG8_STAGE(PG8_SA(1, 1), a1 + hstep, voffA);
            PG8_WAIT_L(8); PG8_BAR; PG8_WAIT_L(0); PG8_MMA(0, 0, At, B0); PG8_BAR; PG8_SCHED;
            PG8_LDB(B1, 0, 1); PG8_STAGE(PG8_SB(0, 0), b2, voffB);
            PG8_BAR; PG8_WAIT_L(0); PG8_MMA(0, 1, At, B1); PG8_BAR;
            PG8_LDA(At, 0, 1); PG8_STAGE(PG8_SA(0, 0), a2, voffA);
            PG8_BAR; PG8_WAIT_L(0); PG8_MMA(1, 0, At, B0); PG8_BAR; PG8_SCHED;
            PG8_STAGE(PG8_SB(0, 1), b2 + hstep, voffB);
            PG8_WAIT_V(6); PG8_BAR; PG8_MMA(1, 1, At, B1); PG8_BAR;
            PG8_LDB(B0, 1, 0); PG8_SCHED; PG8_LDA(At, 1, 0); PG8_STAGE(PG8_SA(0, 1), a2 + hstep, voffA);
            PG8_WAIT_L(8); PG8_BAR; PG8_WAIT_L(0); PG8_MMA(0, 0, At, B0); PG8_BAR; PG8_SCHED;
            PG8_LDB(B1, 1, 1); PG8_STAGE(PG8_SB(1, 0), b3, voffB);
            PG8_BAR; PG8_WAIT_L(0); PG8_MMA(0, 1, At, B1); PG8_BAR;
            PG8_LDA(At, 1, 1); PG8_STAGE(PG8_SA(1, 0), a3, voffA);
            PG8_BAR; PG8_WAIT_L(0); PG8_MMA(1, 0, At, B0); PG8_BAR; PG8_SCHED;
            PG8_STAGE(PG8_SB(1, 1), b3 + hstep, voffB);
            PG8_WAIT_V(6); PG8_BAR; PG8_MMA(1, 1, At, B1); PG8_BAR;
            }
        }
        if constexpr (ALIGN_EPI) { if (wr == 0) PG8_BAR; }
        if constexpr (!Epi::AFTER_DRAIN) { E(acc, cur, wr, wc, fr, fq); S.done(cur); }
        if (!has_next) break;
#pragma unroll
        for (int a = 0; a < 2; ++a)
#pragma unroll
            for (int b = 0; b < 2; ++b)
#pragma unroll
                for (int m = 0; m < 4; ++m)
#pragma unroll
                    for (int n = 0; n < 2; ++n) acc[a][b][m][n] = (f32x4){0.f, 0.f, 0.f, 0.f};
        cur = nxt; cA = nA; cB = nB; ++ui;
        if constexpr (ALIGN_EPI) { if (wr == 1) PG8_BAR; }
    }
    PG8_WAIT_V(0);
    if constexpr (!ALIGN_EPI) { if (wr == 0) PG8_BAR; }
    PG8_BAR;
    if constexpr (Epi::AFTER_DRAIN) { E.fused(acc, cur, wr, wc, fr, fq, lds, wid, lane); S.done(cur); }
#undef PG8_SA
#undef PG8_SB
#undef PG8_STAGE
#undef PG8_LDA
#undef PG8_LDB
#undef PG8_MMA
#undef PG8_WAIT_V
#undef PG8_WAIT_L
#undef PG8_BAR
#undef PG8_SCHED
}
}

#define DI __device__ __forceinline__
#define LAS __attribute__((address_space(3)))
typedef unsigned short bf16_t;
typedef short bf16x8 __attribute__((ext_vector_type(8)));
typedef float f32x4 __attribute__((ext_vector_type(4)));
typedef float f32x16 __attribute__((ext_vector_type(16)));
typedef unsigned u32x4 __attribute__((ext_vector_type(4)));
typedef unsigned u32x2 __attribute__((ext_vector_type(2)));
constexpr int DM = 1024, NB = 8, SEQ = 4096, NTOK = NB * SEQ, INW = 4096, QKGW = 3072;
constexpr float EPS = 1e-6f, LOG2E = 1.4426950408889634f;
constexpr size_t MiB = 1u << 20;
constexpr size_t WS_CTL = 0, CTL_BYTES = 4096;
constexpr size_t WS_WIN = 2 * MiB, WS_WOUT = 18 * MiB, WS_CS = 22 * MiB, WS_H = 32 * MiB, WS_QKG = 96 * MiB, WS_VT = 288 * MiB, WS_YMIX = 352 * MiB;
constexpr size_t WS_Y = WS_QKG;
constexpr int LDS_BYTES = 135168;
constexpr int NITEM_C = 4096, NITEM_B = 6144, NITEM_A = 6144, NITEMS = NITEM_C + NITEM_B + NITEM_A;
constexpr int TABP = 520;

struct Args {
    const float* x; const int* pos; const float* w_in; const float* w_out; const float* pre_g; const float* post_g; const float* rel;
    const float* lq1; const float* lk1; const float* lq2; const float* lk2; const float* subln;
    float* out; unsigned char* ws;
    float inv_freq[16];
    float lam_init[2];
    float oml[2];
};

DI int opq_s(int v) { asm volatile("" : "+s"(v)); return v; }
DI int lane_id() { int l; asm volatile("v_mbcnt_lo_u32_b32 %0, -1, 0\n\tv_mbcnt_hi_u32_b32 %0, -1, %0" : "=v"(l)); return l; }
DI float wave_sum(float v) {
#pragma unroll
    for (int o = 1; o < 64; o <<= 1) v += __shfl_xor(v, o);
    return v;
}
DI float swap_sum(float v) { auto rr = __builtin_amdgcn_permlane32_swap(__float_as_uint(v), __float_as_uint(v), false, false); return __uint_as_float(rr[0]) + __uint_as_float(rr[1]); }
DI float swap_max(float v) { auto rr = __builtin_amdgcn_permlane32_swap(__float_as_uint(v), __float_as_uint(v), false, false); return fmaxf(__uint_as_float(rr[0]), __uint_as_float(rr[1])); }
DI float ex2(float v) { return __builtin_amdgcn_exp2f(v); }
DI float lg2(float v) { return __builtin_amdgcn_logf(v); }
DI bf16x8 ld16(const bf16_t* p) { return *(const bf16x8*)p; }
#define MFMA32(a, b, c) __builtin_amdgcn_mfma_f32_32x32x16_bf16((a), (b), (c), 0, 0, 0)
DI bf16x8 pack8(float a0, float a1, float a2, float a3, float a4, float a5, float a6, float a7) {
    u32x4 w; w.x = pg8::cvt_pk_bf16(a0, a1); w.y = pg8::cvt_pk_bf16(a2, a3); w.z = pg8::cvt_pk_bf16(a4, a5); w.w = pg8::cvt_pk_bf16(a6, a7);
    return __builtin_bit_cast(bf16x8, w);
}

DI void transpose_item(const float* W, int K, int N, bf16_t* WT, int k0, int n0, int dst_row0, LAS float* scr, int lane) {
#pragma unroll 8
    for (int i = 0; i < 32; ++i) { const int kk = 2 * i + (lane >> 5); scr[kk * 33 + (lane & 31)] = W[(size_t)(k0 + kk) * N + n0 + (lane & 31)]; }
    asm volatile("s_waitcnt lgkmcnt(0)" ::: "memory");
    const int c = lane & 7;
#pragma unroll
    for (int j = 0; j < 4; ++j) { const int n = (lane >> 3) + 8 * j; const LAS float* s = scr + (8 * c) * 33 + n;
        u32x4 o; o.x = pg8::cvt_pk_bf16(s[0 * 33], s[1 * 33]); o.y = pg8::cvt_pk_bf16(s[2 * 33], s[3 * 33]); o.z = pg8::cvt_pk_bf16(s[4 * 33], s[5 * 33]); o.w = pg8::cvt_pk_bf16(s[6 * 33], s[7 * 33]);
        *(u32x4*)(WT + (size_t)(dst_row0 + n) * K + k0 + 8 * c) = o; }
    asm volatile("s_waitcnt lgkmcnt(0)" ::: "memory");
}
DI int win_dest(int n0) {
    int grp_off, T, rem;
    if (n0 < 1536) { T = n0 / 384; rem = n0 % 384; grp_off = 0; }
    else if (n0 < 3072) { const int n1 = n0 - 1536; T = n1 / 384; rem = n1 % 384; grp_off = 384; }
    else { const int n1 = n0 - 3072; T = n1 / 256; rem = n1 % 256; grp_off = 768; }
    const int tm = (T == 0) ? 0 : (T == 1) ? 1 : (T == 2) ? 3 : 2;
    return tm * 1024 + grp_off + rem;
}
DI void prenorm_row(const float* xrow, const float* g, bf16_t* hrow, int lane) {
    f32x4 v[4]; float s = 0.f;
#pragma unroll
    for (int j = 0; j < 4; ++j) { v[j] = ((const f32x4*)xrow)[lane + 64 * j]; s += (v[j][0] * v[j][0] + v[j][1] * v[j][1]) + (v[j][2] * v[j][2] + v[j][3] * v[j][3]); }
    const float r = 1.f / sqrtf(wave_sum(s) * (1.f / DM) + EPS);
#pragma unroll
    for (int j = 0; j < 4; ++j) { const f32x4 gg = ((const f32x4*)g)[lane + 64 * j];
        u32x2 o; o.x = pg8::cvt_pk_bf16(v[j][0] * r * gg[0], v[j][1] * r * gg[1]); o.y = pg8::cvt_pk_bf16(v[j][2] * r * gg[2], v[j][3] * r * gg[3]);
        ((u32x2*)hrow)[lane + 64 * j] = o; }
}

DI int sigma32(int m) { return (m & 0x13) | ((m & 4) << 1) | ((m & 8) >> 1); }

DI void gate_store(const f32x16& o0, const f32x16& o1, const bf16_t* gp, bf16_t* yp) {
#pragma unroll
    for (int db = 0; db < 2; ++db)
#pragma unroll
        for (int gq = 0; gq < 4; ++gq) { const int off = 32 * db + 8 * gq;
            const u32x2 gw = *(const u32x2*)(gp + off);
            const float g0 = __uint_as_float(gw.x << 16), g1 = __uint_as_float(gw.x & 0xffff0000u), g2 = __uint_as_float(gw.y << 16), g3 = __uint_as_float(gw.y & 0xffff0000u);
            const float v0 = db ? o1[4 * gq + 0] : o0[4 * gq + 0], v1 = db ? o1[4 * gq + 1] : o0[4 * gq + 1], v2 = db ? o1[4 * gq + 2] : o0[4 * gq + 2], v3 = db ? o1[4 * gq + 3] : o0[4 * gq + 3];
            const float y0 = v0 * g0 * __builtin_amdgcn_rcpf(1.f + ex2(-g0 * LOG2E)), y1 = v1 * g1 * __builtin_amdgcn_rcpf(1.f + ex2(-g1 * LOG2E));
            const float y2 = v2 * g2 * __builtin_amdgcn_rcpf(1.f + ex2(-g2 * LOG2E)), y3 = v3 * g3 * __builtin_amdgcn_rcpf(1.f + ex2(-g3 * LOG2E));
            u32x2 w; w.x = pg8::cvt_pk_bf16(y0, y1); w.y = pg8::cvt_pk_bf16(y2, y3); *(u32x2*)(yp + off) = w; }
}

#define LOADK64(kf, kptr) do { _Pragma("unroll") for (int blk_ = 0; blk_ < 2; ++blk_) _Pragma("unroll") for (int d0_ = 0; d0_ < 4; ++d0_) kf[blk_][d0_] = ld16((kptr) + (size_t)(32 * blk_) * QKGW + 16 * d0_); } while (0)
#define LOADV64(vf, vptr) do { _Pragma("unroll") for (int db_ = 0; db_ < 2; ++db_) _Pragma("unroll") for (int ks_ = 0; ks_ < 4; ++ks_) vf[db_][ks_] = ld16((vptr) + (size_t)(32 * db_) * NTOK + 16 * ks_); } while (0)

DI void attn_A(const bf16_t* QKG, const bf16_t* Vt, bf16_t* Y, int b, int u, int qb32, int lane) {
    const int r32 = lane & 31, hi = lane >> 5; const int t0 = qb32 * 32, t = t0 + r32; const size_t tokbase = (size_t)b * SEQ;
    const bf16_t* qp = QKG + (tokbase + t) * QKGW + u * 64 + hi * 8;
    bf16x8 qf[4];
#pragma unroll
    for (int d0 = 0; d0 < 4; ++d0) qf[d0] = ld16(qp + 16 * d0);
    const bf16_t* kbase = QKG + (tokbase + sigma32(r32)) * QKGW + 1024 + u * 64 + hi * 8;
    const bf16_t* vbase = Vt + (size_t)(u * 64 + r32) * NTOK + tokbase + hi * 8;
    f32x16 o0 = {}, o1 = {};
    float R = 0.f;
    const int kt_diag = t0 >> 6;
    bf16x8 kf[2][4];
    LOADK64(kf, kbase + (size_t)(kt_diag * 64) * QKGW);
    for (int kt = kt_diag; kt >= 0; --kt) {
        const int key0 = kt * 64;
        bf16x8 vf[2][4];
        LOADV64(vf, vbase + key0);
        f32x16 p[2]; p[0] = f32x16{}; p[1] = f32x16{};
#pragma unroll
        for (int d0 = 0; d0 < 4; ++d0) { p[0] = MFMA32(kf[0][d0], qf[d0], p[0]); p[1] = MFMA32(kf[1][d0], qf[d0], p[1]); }
        if (kt > 0) LOADK64(kf, kbase + (size_t)(key0 - 64) * QKGW);
        const bool diag = (kt == kt_diag);
        float sps[4][8], g[4], T[4];
#pragma unroll
        for (int a = 0; a < 4; ++a) { float gs = 0.f;
#pragma unroll
            for (int i = 0; i < 8; ++i) { const float z = p[a >> 1][8 * (a & 1) + i];
                float sp = fmaxf(z, 0.f) + lg2(1.f + ex2(-fabsf(z)));
                if (diag) { const int kidx = key0 + 16 * a + 8 * hi + i; if (kidx >= t) sp = 0.f; }
                sps[a][i] = sp; p[a >> 1][8 * (a & 1) + i] = z - sp; gs += sp; }
            g[a] = gs; T[a] = swap_sum(gs); }
        bf16x8 pf[4];
        float later = 0.f;
#pragma unroll
        for (int a = 3; a >= 0; --a) {
            float e = later + (hi == 0 ? (T[a] - g[a]) : 0.f);
            float w[8];
#pragma unroll
            for (int i = 7; i >= 0; --i) { float wv = ex2(p[a >> 1][8 * (a & 1) + i] - e + R);
                if (diag) { const int kidx = key0 + 16 * a + 8 * hi + i; if (kidx >= t) wv = 0.f; }
                w[i] = wv; e += sps[a][i]; }
            pf[a] = pack8(w[0], w[1], w[2], w[3], w[4], w[5], w[6], w[7]);
            later += T[a];
        }
        R -= later;
#pragma unroll
        for (int ks = 0; ks < 4; ++ks) { o0 = MFMA32(vf[0][ks], pf[ks], o0); o1 = MFMA32(vf[1][ks], pf[ks], o1); }
        if (__all(R < -160.f)) break;
    }
    gate_store(o0, o1, QKG + (tokbase + t) * QKGW + 2048 + u * 64 + 4 * hi, Y + (tokbase + t) * DM + u * 64 + 4 * hi);
}

constexpr int KVP = 144, KVIMG = 64 * KVP, KVBUF = 2 * KVIMG;
#define LDSK(buf, blk, d0) (*(const LAS bf16x8*)((buf) + kro + (blk) * (32 * KVP) + (d0) * 32))
#define LDSV(buf, db, ks) (*(const LAS bf16x8*)((buf) + KVIMG + vro + (db) * (32 * KVP) + (ks) * 32))
#define SOFTMAX_PV(P, M, L, OA, OB) do { \
            float tm = P[0][0]; \
            _Pragma("unroll") for (int r = 1; r < 16; ++r) tm = fmaxf(tm, P[0][r]); \
            _Pragma("unroll") for (int r = 0; r < 16; ++r) tm = fmaxf(tm, P[1][r]); \
            tm = swap_max(tm); \
            const float mn = fmaxf(M, tm), alpha = ex2(M - mn); M = mn; \
            float ls = 0.f; \
            _Pragma("unroll") for (int r = 0; r < 16; ++r) { P[0][r] = ex2(P[0][r] - mn); P[1][r] = ex2(P[1][r] - mn); ls += P[0][r] + P[1][r]; } \
            L = L * alpha + ls; \
            _Pragma("unroll") for (int r = 0; r < 16; ++r) { OA[r] *= alpha; OB[r] *= alpha; } \
            bf16x8 pf[4]; \
            _Pragma("unroll") for (int a = 0; a < 4; ++a) { const int bb = 8 * (a & 1); const f32x16& pp = P[a >> 1]; \
                pf[a] = pack8(pp[bb + 0], pp[bb + 1], pp[bb + 2], pp[bb + 3], pp[bb + 4], pp[bb + 5], pp[bb + 6], pp[bb + 7]); } \
            _Pragma("unroll") for (int ks = 0; ks < 4; ++ks) { OA = MFMA32(vf[0][ks], pf[ks], OA); OB = MFMA32(vf[1][ks], pf[ks], OB); } \
        } while (0)

DI void attn_C_blk(LAS unsigned char* ring, const bf16_t* QKG, const bf16_t* Vt, bf16_t* Y, const float* subg, float lam, float oml, int b, int u, int cgp, int wave, int lane) {
    const int r32 = lane & 31, hi = lane >> 5; const int t0 = cgp * 256 + wave * 32, t = t0 + r32; const size_t tokbase = (size_t)b * SEQ;
    const bf16_t* qp = QKG + (tokbase + t) * QKGW + u * 64 + hi * 8;
    bf16x8 qf[2][2];
#pragma unroll
    for (int cc = 0; cc < 2; ++cc)
#pragma unroll
        for (int d0 = 0; d0 < 2; ++d0) qf[cc][d0] = ld16(qp + 32 * cc + 16 * d0);
    const int srow = (wave * 64 + lane) >> 3, sch = lane & 7;
    const bf16_t* kg = QKG + (tokbase + srow) * QKGW + 1024 + u * 64 + 8 * sch;
    const bf16_t* vg = Vt + (size_t)(u * 64 + srow) * NTOK + tokbase + 8 * sch;
    const unsigned wofs = srow * KVP + sch * 16;
    const unsigned kro = sigma32(r32) * KVP + hi * 16, vro = r32 * KVP + hi * 16;
    f32x16 oa0 = {}, oa1 = {}, ob0 = {}, ob1 = {};
    float m1 = -1e30f, l1 = 0.f, m2 = -1e30f, l2 = 0.f;
    const int c = t0 >> 6, cmax = 4 * cgp + 3;
    bf16x8 kreg = ld16(kg), vreg = ld16(vg);
    *(LAS bf16x8*)(ring + wofs) = kreg; *(LAS bf16x8*)(ring + KVIMG + wofs) = vreg;
    __syncthreads();
    for (int kt = 0; kt <= cmax; ++kt) {
        const LAS unsigned char* buf = ring + (kt & 1) * KVBUF;
        if (kt < cmax) { kreg = ld16(kg + (size_t)((kt + 1) * 64) * QKGW); vreg = ld16(vg + (kt + 1) * 64); }
        if (kt <= c) {
            bf16x8 vf[2][4];
#pragma unroll
            for (int db = 0; db < 2; ++db)
#pragma unroll
                for (int ks = 0; ks < 4; ++ks) vf[db][ks] = LDSV(buf, db, ks);
            f32x16 p[2]; p[0] = f32x16{}; p[1] = f32x16{};
#pragma unroll
            for (int d0 = 0; d0 < 2; ++d0) { p[0] = MFMA32(LDSK(buf, 0, d0), qf[0][d0], p[0]); p[1] = MFMA32(LDSK(buf, 1, d0), qf[0][d0], p[1]); }
            SOFTMAX_PV(p, m1, l1, oa0, oa1);
            p[0] = f32x16{}; p[1] = f32x16{};
#pragma unroll
            for (int d0 = 0; d0 < 2; ++d0) { p[0] = MFMA32(LDSK(buf, 0, 2 + d0), qf[1][d0], p[0]); p[1] = MFMA32(LDSK(buf, 1, 2 + d0), qf[1][d0], p[1]); }
            SOFTMAX_PV(p, m2, l2, ob0, ob1);
        }
        if (kt < cmax) { LAS unsigned char* nb = ring + ((kt + 1) & 1) * KVBUF; *(LAS bf16x8*)(nb + wofs) = kreg; *(LAS bf16x8*)(nb + KVIMG + wofs) = vreg; }
        __syncthreads();
    }
    const float r1 = 1.f / swap_sum(l1), r2 = lam / swap_sum(l2);
    float ss = 0.f;
#pragma unroll
    for (int r = 0; r < 16; ++r) { oa0[r] = oa0[r] * r1 - ob0[r] * r2; oa1[r] = oa1[r] * r1 - ob1[r] * r2; ss += oa0[r] * oa0[r] + oa1[r] * oa1[r]; }
    ss = swap_sum(ss);
    const float rn = (1.f / sqrtf(ss * (1.f / 64.f) + EPS)) * oml;
#pragma unroll
    for (int r = 0; r < 16; ++r) { const int d = 8 * (r >> 2) + 4 * hi + (r & 3); oa0[r] *= rn * subg[d]; oa1[r] *= rn * subg[32 + d]; }
    gate_store(oa0, oa1, QKG + (tokbase + t) * QKGW + 2048 + u * 64 + 4 * hi, Y + (tokbase + t) * DM + u * 64 + 4 * hi);
}

DI void attn_B_blk(LAS unsigned char* ring, const bf16_t* QKG, const bf16_t* Vt, bf16_t* Y, const LAS float* tab, int b, int u, int cgp, int wave, int lane) {
    const int r32 = lane & 31, hi = lane >> 5; const int t0 = cgp * 256 + wave * 32, t = t0 + r32; const size_t tokbase = (size_t)b * SEQ;
    const bf16_t* qp = QKG + (tokbase + t) * QKGW + u * 64 + hi * 8;
    bf16x8 qf[4];
#pragma unroll
    for (int d0 = 0; d0 < 4; ++d0) qf[d0] = ld16(qp + 16 * d0);
    const int srow = (wave * 64 + lane) >> 3, sch = lane & 7;
    const bf16_t* kg = QKG + (tokbase + srow) * QKGW + 1024 + u * 64 + 8 * sch;
    const bf16_t* vg = Vt + (size_t)(u * 64 + srow) * NTOK + tokbase + 8 * sch;
    const unsigned wofs = srow * KVP + sch * 16;
    const unsigned kro = sigma32(r32) * KVP + hi * 16, vro = r32 * KVP + hi * 16;
    const LAS float* tb = tab + (u - 6) * TABP;
    const float bias_far = tb[512];
    f32x16 o0 = {}, o1 = {};
    float m = -1e30f, l = 0.f;
    const int c = t0 >> 6, cmax = 4 * cgp + 3, klo = (4 * cgp - 8 > 0) ? (4 * cgp - 8) : 0;
    bf16x8 kreg = ld16(kg + (size_t)(klo * 64) * QKGW), vreg = ld16(vg + klo * 64);
    *(LAS bf16x8*)(ring + (klo & 1) * KVBUF + wofs) = kreg; *(LAS bf16x8*)(ring + (klo & 1) * KVBUF + KVIMG + wofs) = vreg;
    __syncthreads();
    for (int kt = klo; kt <= cmax; ++kt) {
        const LAS unsigned char* buf = ring + (kt & 1) * KVBUF;
        if (kt < cmax) { kreg = ld16(kg + (size_t)((kt + 1) * 64) * QKGW); vreg = ld16(vg + (kt + 1) * 64); }
        if (kt <= c && kt >= c - 8) {
            const int key0 = kt * 64;
            bf16x8 vf[2][4];
#pragma unroll
            for (int db = 0; db < 2; ++db)
#pragma unroll
                for (int ks = 0; ks < 4; ++ks) vf[db][ks] = LDSV(buf, db, ks);
            f32x16 p[2]; p[0] = f32x16{}; p[1] = f32x16{};
#pragma unroll
            for (int d0 = 0; d0 < 4; ++d0) { p[0] = MFMA32(LDSK(buf, 0, d0), qf[d0], p[0]); p[1] = MFMA32(LDSK(buf, 1, d0), qf[d0], p[1]); }
            if (c - kt >= 5) {
#pragma unroll
                for (int r = 0; r < 16; ++r) { p[0][r] += bias_far; p[1][r] += bias_far; }
            } else {
#pragma unroll
                for (int a = 0; a < 4; ++a)
#pragma unroll
                    for (int i = 0; i < 8; ++i) { const int kidx = key0 + 16 * a + 8 * hi + i; int rel = t - kidx; rel = rel < -256 ? -256 : (rel > 256 ? 256 : rel);
                        p[a >> 1][8 * (a & 1) + i] += tb[rel + 256]; }
            }
            SOFTMAX_PV(p, m, l, o0, o1);
        }
        if (kt < cmax) { LAS unsigned char* nb = ring + ((kt + 1) & 1) * KVBUF; *(LAS bf16x8*)(nb + wofs) = kreg; *(LAS bf16x8*)(nb + KVIMG + wofs) = vreg; }
        __syncthreads();
    }
    const float rl = 1.f / swap_sum(l);
#pragma unroll
    for (int r = 0; r < 16; ++r) { o0[r] *= rl; o1[r] *= rl; }
    gate_store(o0, o1, QKG + (tokbase + t) * QKGW + 2048 + u * 64 + 4 * hi, Y + (tokbase + t) * DM + u * 64 + 4 * hi);
}
#undef SOFTMAX_PV

__global__ void __launch_bounds__(512) fwd_mega(Args a) {
    extern __shared__ __attribute__((aligned(16))) unsigned char lds_raw[];
    cg::grid_group grid = cg::this_grid();
    LAS unsigned char* lds = (LAS unsigned char*)lds_raw;
    const int wave = __builtin_amdgcn_readfirstlane((int)threadIdx.x >> 6);
    const int G = gridDim.x, gw = blockIdx.x * 8 + wave, NGW = G * 8;
    unsigned char* ws = a.ws;
    unsigned* ctl = (unsigned*)(ws + WS_CTL);
    bf16_t* WtIn = (bf16_t*)(ws + WS_WIN); bf16_t* WtOut = (bf16_t*)(ws + WS_WOUT); float* CS = (float*)(ws + WS_CS);
    bf16_t* H = (bf16_t*)(ws + WS_H); bf16_t* QKG = (bf16_t*)(ws + WS_QKG); bf16_t* Vt = (bf16_t*)(ws + WS_VT); bf16_t* YM = (bf16_t*)(ws + WS_YMIX); float* Yf = (float*)(ws + WS_Y);

    {
        const int lane = lane_id(), tid = wave * 64 + lane;
        LAS float* scr = (LAS float*)(lds + wave * 16384);
        for (int it = gw; it < 5120; it += NGW) {
            const int layer = it / 2560, r = it % 2560;
            if (r < 2048) { const int kb = r / 128, nb = r % 128; transpose_item(a.w_in + (size_t)layer * DM * INW, DM, INW, WtIn + (size_t)layer * INW * DM, 64 * kb, 32 * nb, win_dest(32 * nb), scr, lane); }
            else { const int r2 = r - 2048, kb = r2 / 32, nb = r2 % 32; transpose_item(a.w_out + (size_t)layer * DM * DM, DM, DM, WtOut + (size_t)layer * DM * DM, 64 * kb, 32 * nb, 32 * nb, scr, lane); }
        }
        for (int e = blockIdx.x * 512 + tid; e < NTOK * 16; e += G * 512) {
            const int tok = e >> 4, i = e & 15;
            const float ang = (float)a.pos[tok] * a.inv_freq[i];
            const double tt = (double)ang * 0.15915494309189535; const float fr = (float)(tt - rint(tt));
            CS[2 * e] = __builtin_amdgcn_cosf(fr); CS[2 * e + 1] = __builtin_amdgcn_sinf(fr);
        }
        for (int row = gw; row < NTOK; row += NGW) prenorm_row(a.x + (size_t)row * DM, a.pre_g, H + (size_t)row * DM, lane);
    }
    grid.sync();

    for (int layer = 0; layer < 2; ++layer) {
        {
            const bf16_t* W = WtIn + (size_t)layer * INW * DM;
            { pg8::Gemm g{H, W, NTOK, QKGW, DM}; pg8::StaticOrder S; S.init(NTOK, QKGW, opq_s(G), opq_s((int)blockIdx.x));
              pg8::EpiQKG E{QKG, CS, 0.125f * LOG2E, 0.17677669529663687f * LOG2E};
              pg8::gemm_phase<pg8::EpiQKG, pg8::StaticOrder, true, true>(lds, g, S, E, wave); }
            { pg8::Gemm g{W + (size_t)QKGW * DM, H, DM, NTOK, DM}; pg8::StaticOrder S; S.init(DM, NTOK, opq_s(G), opq_s((int)blockIdx.x));
              pg8::EpiPlain E{Vt, NTOK};
              pg8::gemm_phase<pg8::EpiPlain, pg8::StaticOrder, true, true>(lds, g, S, E, wave); }
        }
        grid.sync();
        {
            const int lane = lane_id(), tid = wave * 64 + lane;
            LAS float* tab = (LAS float*)lds;
            for (int i = tid; i < 6 * 513; i += 512) tab[(i / 513) * TABP + (i % 513)] = a.rel[layer * 6 * 513 + i] * LOG2E;
            __syncthreads();
            float lam;
            { const float v1 = (lane < 32) ? a.lq1[layer * 32 + lane] * a.lk1[layer * 32 + lane] : 0.f, v2 = (lane < 32) ? a.lq2[layer * 32 + lane] * a.lk2[layer * 32 + lane] : 0.f;
              lam = expf(wave_sum(v1)) - expf(wave_sum(v2)) + a.lam_init[layer];
              lam = __uint_as_float((unsigned)__builtin_amdgcn_readfirstlane((int)__float_as_uint(lam))); }
            unsigned* ctrb = ctl + 64 * (1 + layer), *ctrw = ctl + 64 * (3 + layer);
            LAS unsigned* itw = (LAS unsigned*)(lds + 12544);
            LAS unsigned char* ring = lds + 16384;
            for (;;) {
                const int ln = lane_id();
                if (wave == 0 && ln == 0) *itw = atomicAdd(ctrb, 1u);
                __syncthreads();
                const unsigned it = (unsigned)__builtin_amdgcn_readfirstlane((int)*itw);
                __syncthreads();
                if (it >= 1280u) break;
                if (it < 512u) { const int cgp = 15 - (int)(it >> 5), bh = (int)(it & 31);
                    attn_C_blk(ring, QKG, Vt, YM, a.subln + layer * 64, lam, a.oml[layer], bh >> 2, 12 + (bh & 3), cgp, wave, ln); }
                else { const int j = (int)it - 512, cgp = 15 - j / 48, bh = j % 48;
                    attn_B_blk(ring, QKG, Vt, YM, tab, bh / 6, 6 + bh % 6, cgp, wave, ln); }
            }
            for (;;) {
                const int ln = lane_id();
                unsigned it = 0; if (ln == 0) it = atomicAdd(ctrw, 1u);
                it = (unsigned)__builtin_amdgcn_readfirstlane((int)it);
                if (it >= (unsigned)NITEM_A) break;
                const int bh = (int)(it >> 7), qb = (int)(it & 127);
                attn_A(QKG, Vt, YM, bh / 6, bh % 6, qb, ln);
            }
        }
        grid.sync();
        {
            pg8::Gemm g{YM, WtOut + (size_t)layer * DM * DM, NTOK, DM, DM}; pg8::StaticOrder S; S.init(NTOK, DM, opq_s(G), opq_s((int)blockIdx.x));
            pg8::EpiF32 E{Yf, DM};
            pg8::gemm_phase<pg8::EpiF32, pg8::StaticOrder, true, true>(lds, g, S, E, wave);
        }
        grid.sync();
        {
            const float* xprev = (layer == 0) ? a.x : a.out;
            const float* pg = a.post_g + layer * DM;
            const int lane4 = lane_id(), lane = lane4;
            for (int row = gw; row < NTOK; row += NGW) {
                f32x4 y[4], xv[4]; float s = 0.f;
#pragma unroll
                for (int j = 0; j < 4; ++j) { y[j] = ((const f32x4*)(Yf + (size_t)row * DM))[lane4 + 64 * j]; xv[j] = ((const f32x4*)(xprev + (size_t)row * DM))[lane4 + 64 * j];
                    s += (y[j][0] * y[j][0] + y[j][1] * y[j][1]) + (y[j][2] * y[j][2] + y[j][3] * y[j][3]); }
                const float r = 1.f / sqrtf(wave_sum(s) * (1.f / DM) + EPS);
                float s2 = 0.f;
#pragma unroll
                for (int j = 0; j < 4; ++j) { const f32x4 gg = ((const f32x4*)pg)[lane4 + 64 * j]; xv[j] = xv[j] + y[j] * r * gg;
                    ((f32x4*)(a.out + (size_t)row * DM))[lane4 + 64 * j] = xv[j];
                    s2 += (xv[j][0] * xv[j][0] + xv[j][1] * xv[j][1]) + (xv[j][2] * xv[j][2] + xv[j][3] * xv[j][3]); }
                if (layer == 0) {
                    const float r2 = 1.f / sqrtf(wave_sum(s2) * (1.f / DM) + EPS);
#pragma unroll
                    for (int j = 0; j < 4; ++j) { const f32x4 gg = ((const f32x4*)(a.pre_g + DM))[lane4 + 64 * j];
                        u32x2 o; o.x = pg8::cvt_pk_bf16(xv[j][0] * r2 * gg[0], xv[j][1] * r2 * gg[1]); o.y = pg8::cvt_pk_bf16(xv[j][2] * r2 * gg[2], xv[j][3] * r2 * gg[3]);
                        ((u32x2*)(H + (size_t)row * DM))[lane4 + 64 * j] = o; }
                }
            }
        }
        if (layer == 0) grid.sync();
    }
}

extern "C" void kernel_launch(void* const* d_in, const int* in_sizes, int n_in, void* d_out, int out_size, void* d_ws, size_t ws_size, hipStream_t stream) {
    static int grid_blocks = 0;
    if (!grid_blocks) {
        int dev = 0, cus = 0, per_cu = 0;
        hipGetDevice(&dev);
        hipDeviceGetAttribute(&cus, hipDeviceAttributeMultiprocessorCount, dev);
        if (hipFuncSetAttribute((const void*)fwd_mega, hipFuncAttributeMaxDynamicSharedMemorySize, LDS_BYTES) != hipSuccess) fprintf(stderr, "hipFuncSetAttribute failed\n");
        if (hipOccupancyMaxActiveBlocksPerMultiprocessor(&per_cu, (const void*)fwd_mega, 512, LDS_BYTES) != hipSuccess || per_cu < 1) { fprintf(stderr, "occupancy query: %d\n", per_cu); per_cu = 1; }
        (void)hipGetLastError();
        grid_blocks = cus * per_cu;
    }
    hipMemsetAsync((char*)d_ws + WS_CTL, 0, CTL_BYTES, stream);
    Args a{};
    a.x = (const float*)d_in[0]; a.pos = (const int*)d_in[1]; a.w_in = (const float*)d_in[2]; a.w_out = (const float*)d_in[3];
    a.pre_g = (const float*)d_in[4]; a.post_g = (const float*)d_in[5]; a.rel = (const float*)d_in[6];
    a.lq1 = (const float*)d_in[7]; a.lk1 = (const float*)d_in[8]; a.lq2 = (const float*)d_in[9]; a.lk2 = (const float*)d_in[10]; a.subln = (const float*)d_in[11];
    a.out = (float*)d_out; a.ws = (unsigned char*)d_ws;
    for (int i = 0; i < 16; ++i) a.inv_freq[i] = powf(10000.0f, -(float)i / 16.0f);
    for (int l = 0; l < 2; ++l) { a.lam_init[l] = (float)(0.8 - 0.6 * exp(-0.3 * (double)l)); a.oml[l] = 1.0f - a.lam_init[l]; }
    void* args[] = {&a};
    hipError_t e = hipLaunchCooperativeKernel((const void*)fwd_mega, dim3(grid_blocks), dim3(512), args, LDS_BYTES, stream);
    if (e != hipSuccess) fprintf(stderr, "cooperative launch failed: %s (grid %d)\n", hipGetErrorString(e), grid_blocks);
}
```
